# Optimizing an MI355X kernel written in HIP

```python
import math
import jax, jax.numpy as jnp
from jax import lax
import numpy as np

D_MODEL = 1024
BATCH = 32
SEQ = 2048
DEPTH = 4

N_MIXERS = 2
N_S5_LAYERS = (DEPTH + 1) // 2
N_POOL_LAYERS = DEPTH // 2
S5_GROUP_CH = 16
S5_GROUPS = D_MODEL // S5_GROUP_CH
S5_STATE = 64
S5_CHUNK = 128
DT_MIN = 1e-3
DT_MAX = 1e-1
POOL_WINDOWS = (2, 4, 8, 16)
POOL_GROUPS = len(POOL_WINDOWS)
POOL_GROUP_CH = D_MODEL // POOL_GROUPS
D_FF = 2816
CONV_WIDTH = 3
RMS_EPS = 1e-6

kernel_name = "hybrid_s5_pool_convffn"


def rms_norm(x, gain):
    xf = x.astype(jnp.float32)
    y = xf * lax.rsqrt(jnp.mean(xf * xf, axis=-1, keepdims=True) + RMS_EPS)
    return (y * gain.astype(jnp.float32)).astype(x.dtype)


def _complex_affine_combine(e1, e2):
    a1r, a1i, b1r, b1i = e1
    a2r, a2i, b2r, b2i = e2
    ar = a2r * a1r - a2i * a1i
    ai = a2r * a1i + a2i * a1r
    br = a2r * b1r - a2i * b1i + b2r
    bi = a2r * b1i + a2i * b1r + b2i
    return ar, ai, br, bi


def s5_mixer(u, lam_re, lam_im, log_dt, b_re, b_im, c_re, c_im, d_skip, w_glu, b_glu):
    f32 = jnp.float32
    bsz, l, d = u.shape
    lr, li = lam_re.astype(f32), lam_im.astype(f32)
    dt = jnp.exp(log_dt.astype(f32))[:, None]
    mag = jnp.exp(lr * dt)
    ab_re = mag * jnp.cos(li * dt)
    ab_im = mag * jnp.sin(li * dt)
    den = lr * lr + li * li
    nr = ab_re - 1.0
    ni = ab_im
    f_re = ((nr * lr + ni * li) / den)[..., None]
    f_im = ((ni * lr - nr * li) / den)[..., None]
    br, bi = b_re.astype(f32), b_im.astype(f32)
    bb_re = f_re * br - f_im * bi
    bb_im = f_re * bi + f_im * br
    cr, ci = c_re.astype(f32), c_im.astype(f32)

    n_chunks = l // S5_CHUNK
    uf = u.astype(f32)
    u_chunks = uf.reshape(bsz, n_chunks, S5_CHUNK, S5_GROUPS, S5_GROUP_CH).transpose(1, 0, 2, 3, 4)
    a_re = jnp.broadcast_to(ab_re, (1, S5_CHUNK, S5_GROUPS, S5_STATE))
    a_im = jnp.broadcast_to(ab_im, (1, S5_CHUNK, S5_GROUPS, S5_STATE))

    def step(carry, u_c):
        h0r, h0i = carry
        xr = jnp.einsum('bcgh,gph->bcgp', u_c, bb_re)
        xi = jnp.einsum('bcgh,gph->bcgp', u_c, bb_im)
        pr, pi_, sr, si = lax.associative_scan(_complex_affine_combine, (a_re, a_im, xr, xi), axis=1)
        h0r_, h0i_ = h0r[:, None], h0i[:, None]
        hr = sr + pr * h0r_ - pi_ * h0i_
        hi = si + pr * h0i_ + pi_ * h0r_
        y = jnp.einsum('bcgp,ghp->bcgh', hr, cr) - jnp.einsum('bcgp,ghp->bcgh', hi, ci)
        return (hr[:, -1], hi[:, -1]), y

    init = (jnp.zeros((bsz, S5_GROUPS, S5_STATE), f32), jnp.zeros((bsz, S5_GROUPS, S5_STATE), f32))
    _, ys = lax.scan(step, init, u_chunks)
    y = ys.transpose(1, 0, 2, 3, 4).reshape(bsz, l, d) + d_skip.astype(f32) * uf
    y = jax.nn.gelu(y)
    out = y * jax.nn.sigmoid(y @ w_glu.astype(f32) + b_glu.astype(f32))
    return out.astype(u.dtype)


def pool_mixer(u, w_group, scale):
    f32 = jnp.float32
    bsz, l, d = u.shape
    uf = u.astype(f32)
    cs = jnp.concatenate([jnp.zeros((bsz, 1, d), f32), jnp.cumsum(uf, axis=1)], axis=1)
    t = jnp.arange(1, l + 1, dtype=f32)
    pooled = []
    for g, win in enumerate(POOL_WINDOWS):
        csg = cs[:, :, g * POOL_GROUP_CH:(g + 1) * POOL_GROUP_CH]
        upper = csg[:, 1:]
        lower = jnp.pad(csg, ((0, 0), (win - 1, 0), (0, 0)))[:, :l]
        count = jnp.minimum(t, float(win))[None, :, None]
        pooled.append((upper - lower) / count)
    pooled = jnp.stack(pooled, axis=2)
    diff = pooled - uf.reshape(bsz, l, POOL_GROUPS, POOL_GROUP_CH)
    out = jnp.einsum('bsgc,gcd->bsgd', diff, w_group.astype(f32)).reshape(bsz, l, d)
    return (out * scale.astype(f32)).astype(u.dtype)


def conv_ffn(u, w_gate, w_val, conv_w, conv_b, w_down):
    l = u.shape[1]
    g = u @ w_gate
    gp = jnp.pad(g, ((0, 0), (CONV_WIDTH - 1, 0), (0, 0)))
    gc = conv_b + conv_w[0] * gp[:, 0:l]
    for k in range(1, CONV_WIDTH):
        gc = gc + conv_w[k] * gp[:, k:k + l]
    hdn = jax.nn.gelu(gc) * (u @ w_val)
    return hdn @ w_down


def setup_inputs(seed: int = 0) -> dict:
    key = jax.random.key(seed)
    ks = jax.random.split(key, 22)
    f32 = jnp.float32
    na, nb = N_S5_LAYERS, N_POOL_LAYERS
    G, P, H, D, F = S5_GROUPS, S5_STATE, S5_GROUP_CH, D_MODEL, D_FF
    nrm = lambda k, s: jax.random.normal(k, s, f32)
    n_idx = jnp.arange(P, dtype=f32)
    return {
        "x": nrm(ks[0], (BATCH, SEQ, D)),
        "s5_lambda_re": -0.5 + 0.01 * nrm(ks[1], (na, G, P)),
        "s5_lambda_im": math.pi * n_idx + 0.01 * nrm(ks[2], (na, G, P)),
        "s5_log_dt": jax.random.uniform(ks[3], (na, G), f32, math.log(DT_MIN), math.log(DT_MAX)),
        "s5_b_re": nrm(ks[4], (na, G, P, H)) * (2 * H) ** -0.5,
        "s5_b_im": nrm(ks[5], (na, G, P, H)) * (2 * H) ** -0.5,
        "s5_c_re": nrm(ks[6], (na, G, H, P)) * P ** -0.5,
        "s5_c_im": nrm(ks[7], (na, G, H, P)) * P ** -0.5,
        "s5_d": nrm(ks[8], (na, D)),
        "s5_w_glu": nrm(ks[9], (na, D, D)) * D ** -0.5,
        "s5_b_glu": 0.01 * nrm(ks[10], (na, D)),
        "pool_w": nrm(ks[11], (nb, POOL_GROUPS, POOL_GROUP_CH, POOL_GROUP_CH)) * POOL_GROUP_CH ** -0.5,
        "pool_scale": 1.0 + 0.1 * nrm(ks[12], (nb, D)),
        "ffn_w_gate": nrm(ks[13], (DEPTH, D, F)) * D ** -0.5,
        "ffn_w_val": nrm(ks[14], (DEPTH, D, F)) * D ** -0.5,
        "ffn_conv_w": nrm(ks[15], (DEPTH, CONV_WIDTH, F)) * CONV_WIDTH ** -0.5,
        "ffn_conv_b": 0.01 * nrm(ks[16], (DEPTH, F)),
        "ffn_w_down": nrm(ks[17], (DEPTH, F, D)) * F ** -0.5,
        "norm_mix_pre": 1.0 + 0.05 * nrm(ks[18], (DEPTH, D)),
        "norm_mix_post": 1.0 + 0.05 * nrm(ks[19], (DEPTH, D)),
        "norm_ffn_pre": 1.0 + 0.05 * nrm(ks[20], (DEPTH, D)),
        "norm_ffn_post": 1.0 + 0.05 * nrm(ks[21], (DEPTH, D)),
    }


def reference(x, s5_lambda_re, s5_lambda_im, s5_log_dt, s5_b_re, s5_b_im, s5_c_re, s5_c_im,
              s5_d, s5_w_glu, s5_b_glu, pool_w, pool_scale, ffn_w_gate, ffn_w_val, ffn_conv_w,
              ffn_conv_b, ffn_w_down, norm_mix_pre, norm_mix_post, norm_ffn_pre, norm_ffn_post):
    for i in range(DEPTH):
        j = i // N_MIXERS
        h = rms_norm(x, norm_mix_pre[i])
        if i % N_MIXERS == 0:
            m = s5_mixer(h, s5_lambda_re[j], s5_lambda_im[j], s5_log_dt[j], s5_b_re[j], s5_b_im[j],
                         s5_c_re[j], s5_c_im[j], s5_d[j], s5_w_glu[j], s5_b_glu[j])
        else:
            m = pool_mixer(h, pool_w[j], pool_scale[j])
        x = x + rms_norm(m, norm_mix_post[i])
        h = rms_norm(x, norm_ffn_pre[i])
        f = conv_ffn(h, ffn_w_gate[i], ffn_w_val[i], ffn_conv_w[i], ffn_conv_b[i], ffn_w_down[i])
        x = x + rms_norm(f, norm_ffn_post[i])
    return x
```

```cpp
#include <hip/hip_runtime.h>
#include <hip/hip_cooperative_groups.h>
#include <cstdio>
namespace cg = cooperative_groups;

typedef unsigned short bf16_t;
typedef short bf16x8 __attribute__((ext_vector_type(8)));
typedef float f32x4 __attribute__((ext_vector_type(4)));
typedef unsigned u32x4 __attribute__((ext_vector_type(4)));
typedef unsigned u32x2 __attribute__((ext_vector_type(2)));

constexpr int DM = 1024, NB = 32, SEQ = 2048, NTOK = NB * SEQ, DFF = 2816, DEPTH = 4;
constexpr int NCR = NTOK / 16;
constexpr float RMS_EPS = 1e-6f;

constexpr size_t SZ_W1T = (size_t)4 * 5632 * 1024 * 2, SZ_W2T = (size_t)4 * 1024 * 2816 * 2, SZ_WGT = (size_t)2 * 1024 * 1024 * 2,
                 SZ_WPT = (size_t)2 * 4 * 256 * 256 * 2, SZ_FBD = (size_t)2 * 32 * 256 * 512 * 2, SZ_ME = (size_t)2 * 64 * 256 * 384 * 2,
                 SZ_AT = (size_t)2 * 64 * 64 * 2 * 4, SZ_RSS = (size_t)16 * NTOK * 4, SZ_HALO = (size_t)256 * 2 * DFF * 4,
                 SZ_ACT = (size_t)NTOK * DM * 2, SZ_HDN = (size_t)NTOK * DFF * 2;
constexpr size_t O_W1T = 0, O_W2T = O_W1T + SZ_W1T, O_WGT = O_W2T + SZ_W2T, O_WPT = O_WGT + SZ_WGT, O_FBD = O_WPT + SZ_WPT,
                 O_ME = O_FBD + SZ_FBD, O_AT = O_ME + SZ_ME, O_RSS = O_AT + SZ_AT, O_GTAIL = O_RSS + SZ_RSS, O_GHEAD = O_GTAIL + SZ_HALO,
                 O_VHEAD = O_GHEAD + SZ_HALO, O_HB = O_VHEAD + SZ_HALO, O_YB = O_HB + SZ_ACT, O_MB = O_YB + SZ_ACT, O_HDN = O_MB + SZ_ACT,
                 WS_END = O_HDN + SZ_HDN;
constexpr size_t O_S = O_HDN;
constexpr size_t O_HST = O_HDN + (size_t)32 * 4096 * 256 * 4;
static_assert(O_HST + (size_t)32 * 4096 * 256 * 2 <= WS_END, "alias");
constexpr int LDS_BYTES = 256 * 132 * 4;

struct Params {
  const float *x, *lam_re, *lam_im, *log_dt, *b_re, *b_im, *c_re, *c_im, *s5d, *wglu, *bglu, *poolw, *pscale, *wgate, *wval, *convw, *convb,
      *wdown, *n_mix_pre, *n_mix_post, *n_ffn_pre, *n_ffn_post;
  float* out;
  unsigned char* ws;
};

extern __shared__ __attribute__((aligned(16))) char smem[];

#define PHASE_IDS() int tid; asm volatile("v_mbcnt_lo_u32_b32 %0, -1, 0\n\tv_mbcnt_hi_u32_b32 %0, -1, %0" : "=v"(tid)); tid |= (wv << 6); int bid = blockIdx.x; asm volatile("" : "+s"(bid)); unsigned char* ws = p.ws; asm volatile("" : "+s"(ws)); const int nblk = gridDim.x; (void)bid; (void)ws; (void)nblk
__device__ __forceinline__ unsigned pk2(float lo, float hi) { unsigned r; asm("v_cvt_pk_bf16_f32 %0, %1, %2" : "=v"(r) : "v"(lo), "v"(hi)); return r; }
__device__ __forceinline__ float bf_lo(unsigned u) { return __uint_as_float(u << 16); }
__device__ __forceinline__ float bf_hi(unsigned u) { return __uint_as_float(u & 0xffff0000u); }
__device__ __forceinline__ float sigmoid_f(float z) { return __builtin_amdgcn_rcpf(1.0f + __builtin_amdgcn_exp2f(-1.4426950408889634f * z)); }
__device__ __forceinline__ float gelu_f(float v) {
  const float u = v * (1.0f + 0.044715f * v * v);
  return v * sigmoid_f(1.5957691216057308f * u);
}
__device__ __forceinline__ float wave_sum(float v) {
#pragma unroll
  for (int o = 1; o < 64; o <<= 1) v += __shfl_xor(v, o);
  return v;
}
__device__ __forceinline__ int perm32(int rho) { const int n = rho >> 4, i = rho & 15; return 8 * (i >> 2) + 4 * n + (i & 3); }
__device__ __forceinline__ int slot2col(int R) { return (R & ~31) + perm32(R & 31); }

constexpr int HT = 128 * 64;
__device__ __forceinline__ int lds_byte(int r, int c) {
  int st = (r >> 4) * 2 + (c >> 5), rr = r & 15, cc = c & 31, ob = rr * 64 + cc * 2;
  return st * 1024 + (ob ^ (((ob >> 9) & 1) << 5));
}
struct GemmDesc { const bf16_t* A; const bf16_t* A2; const bf16_t* Bt; int lda, lda2, ldb, ksplit, nt; };

__device__ __forceinline__ void gemm_kloop(const GemmDesc& g, f32x4 (&acc)[2][2][4][2], const int tid) {
  bf16_t* shm = (bf16_t*)smem;
  const int wid = tid >> 6, lane = tid & 63, wr = wid >> 2, wc = wid & 3, fr = lane & 15, fq = lane >> 4;
  int s_r, s_c;
  { const int sb = lane * 16, swz = sb ^ (((sb >> 9) & 1) << 5); s_r = (wid >> 1) * 16 + swz / 64; s_c = (wid & 1) * 32 + (swz % 64) / 2; }
#define SA(b, h) (shm + ((b) * 2 + (h)) * HT)
#define SB(b, h) (shm + (4 + (b) * 2 + (h)) * HT)
#define STAGE_A(P, half, kt) do { const bf16_t* _base; long _ld; \
    if ((kt) < g.ksplit) { _base = g.A + (long)(kt) * 64; _ld = g.lda; } else { _base = g.A2 + (long)((kt) - g.ksplit) * 64; _ld = g.lda2; } \
    _base += (long)((half) * 128 + s_r) * _ld + s_c; \
    __builtin_amdgcn_global_load_lds((const unsigned*)(_base), (unsigned*)((char*)(P) + tid * 16), 16, 0, 0); \
    __builtin_amdgcn_global_load_lds((const unsigned*)(_base + 64 * _ld), (unsigned*)((char*)(P) + tid * 16 + 8192), 16, 0, 0); } while (0)
#define STAGE_B(P, half, kt) do { const bf16_t* _base = g.Bt + (long)(kt) * 64 + (long)((half) * 128 + s_r) * g.ldb + s_c; \
    __builtin_amdgcn_global_load_lds((const unsigned*)(_base), (unsigned*)((char*)(P) + tid * 16), 16, 0, 0); \
    __builtin_amdgcn_global_load_lds((const unsigned*)(_base + 64 * (long)g.ldb), (unsigned*)((char*)(P) + tid * 16 + 8192), 16, 0, 0); } while (0)
#define LDA(dst, b, h) for (int m = 0; m < 4; ++m) for (int k = 0; k < 2; ++k) \
    dst[m][k] = *reinterpret_cast<const bf16x8*>((char*)SA(b, h) + lds_byte(wr * 64 + m * 16 + fr, k * 32 + fq * 8))
#define LDB(dst, b, h) for (int n = 0; n < 2; ++n) for (int k = 0; k < 2; ++k) \
    dst[n][k] = *reinterpret_cast<const bf16x8*>((char*)SB(b, h) + lds_byte(wc * 32 + n * 16 + fr, k * 32 + fq * 8))
#define MMA(ai, bj, At_, Bt_) do { __builtin_amdgcn_s_setprio(1); \
    for (int m = 0; m < 4; ++m) for (int n = 0; n < 2; ++n) for (int k = 0; k < 2; ++k) \
      acc[ai][bj][m][n] = __builtin_amdgcn_mfma_f32_16x16x32_bf16(Bt_[n][k], At_[m][k], acc[ai][bj][m][n], 0, 0, 0); \
    __builtin_amdgcn_s_setprio(0); } while (0)
#define WAIT_V(n) asm volatile("s_waitcnt vmcnt(" #n ")" ::: "memory")
#define WAIT_L(n) asm volatile("s_waitcnt lgkmcnt(" #n ")" ::: "memory")
#define BAR __builtin_amdgcn_s_barrier()
#define SCHED __builtin_amdgcn_sched_barrier(0)
  bf16x8 At[4][2], B0[2][2], B1[2][2];
  const int nt = g.nt;
#pragma unroll
  for (int a = 0; a < 2; ++a)
#pragma unroll
    for (int b = 0; b < 2; ++b)
#pragma unroll
      for (int m = 0; m < 4; ++m)
#pragma unroll
        for (int n = 0; n < 2; ++n) acc[a][b][m][n] = (f32x4){0.f, 0.f, 0.f, 0.f};
  STAGE_B(SB(0, 0), 0, 0); STAGE_A(SA(0, 0), 0, 0);
  STAGE_B(SB(0, 1), 1, 0); STAGE_A(SA(0, 1), 1, 0);
  if (wr == 1) BAR;
  WAIT_V(4); BAR;
  STAGE_B(SB(1, 0), 0, 1); STAGE_A(SA(1, 0), 0, 1); STAGE_B(SB(1, 1), 1, 1);
  WAIT_V(6); BAR;
  for (int t = 0; t < nt - 2; t += 2) {
    LDB(B0, 0, 0); SCHED; LDA(At, 0, 0); STAGE_A(SA(1, 1), 1, t + 1);
    WAIT_L(8); BAR; WAIT_L(0); MMA(0, 0, At, B0); BAR; SCHED;
    LDB(B1, 0, 1); STAGE_B(SB(0, 0), 0, t + 2);
    BAR; WAIT_L(0); MMA(0, 1, At, B1); BAR;
    LDA(At, 0, 1); STAGE_A(SA(0, 0), 0, t + 2);
    BAR; WAIT_L(0); MMA(1, 0, At, B0); BAR; SCHED;
    STAGE_B(SB(0, 1), 1, t + 2);
    WAIT_V(6); BAR; MMA(1, 1, At, B1); BAR;
    LDB(B0, 1, 0); SCHED; LDA(At, 1, 0); STAGE_A(SA(0, 1), 1, t + 2);
    WAIT_L(8); BAR; WAIT_L(0); MMA(0, 0, At, B0); BAR; SCHED;
    LDB(B1, 1, 1); STAGE_B(SB(1, 0), 0, t + 3);
    BAR; WAIT_L(0); MMA(0, 1, At, B1); BAR;
    LDA(At, 1, 1); STAGE_A(SA(1, 0), 0, t + 3);
    BAR; WAIT_L(0); MMA(1, 0, At, B0); BAR; SCHED;
    STAGE_B(SB(1, 1), 1, t + 3);
    WAIT_V(6); BAR; MMA(1, 1, At, B1); BAR;
  }
  { LDB(B0, 0, 0); LDA(At, 0, 0); STAGE_A(SA(1, 1), 1, nt - 1);
    BAR; WAIT_L(0); MMA(0, 0, At, B0); BAR;
    LDB(B1, 0, 1); BAR; WAIT_L(0); MMA(0, 1, At, B1); BAR;
    LDA(At, 0, 1); WAIT_V(4); BAR; WAIT_L(0); MMA(1, 0, At, B0); MMA(1, 1, At, B1); BAR; }
  { LDB(B0, 1, 0); LDA(At, 1, 0); WAIT_V(2); BAR; WAIT_L(0); MMA(0, 0, At, B0); BAR;
    LDB(B1, 1, 1); WAIT_V(0); BAR; WAIT_L(0); MMA(0, 1, At, B1); BAR;
    LDA(At, 1, 1); BAR; WAIT_L(0); MMA(1, 0, At, B0); MMA(1, 1, At, B1); BAR; }
  if (wr == 0) BAR;
}

__device__ __forceinline__ void tile_map(int L, int nM, int nN, int& pm, int& pn) {
  const int nwg = nM * nN; int wgid = L;
  { const int q = nwg / 8, r = nwg % 8, xcd = wgid % 8, off = wgid / 8; wgid = (xcd < r ? xcd * (q + 1) : r * (q + 1) + (xcd - r) * q) + off; }
  const int nig = 8 * nN, gid = wgid / nig, fm = gid * 8, gsz = (nM - fm) < 8 ? (nM - fm) : 8;
  pm = fm + ((wgid % nig) % gsz); pn = (wgid % nig) / gsz;
}

enum { G_FFN1 = 0, G_FFN2 = 1, G_GLU = 2, G_POOL = 3, G_S = 4, G_Y = 5 };

__device__ __forceinline__ void gemm_phase(const Params& p, const int wv, int kind, int layer) {
  PHASE_IDS();
  const int j2 = layer >> 1;
  int ntiles;
  switch (kind) { case G_FFN1: ntiles = 256 * 22; break; case G_S: ntiles = 512; break; default: ntiles = 1024; }
  for (int L = bid; L < ntiles; L += nblk) {
    GemmDesc g; int pm = 0, pn = 0, grp = 0;
    g.A2 = nullptr; g.lda2 = 0;
    if (kind == G_FFN1) {
      tile_map(L, 256, 22, pm, pn);
      g.A = (const bf16_t*)(ws + O_HB) + (size_t)pm * 256 * 1024; g.lda = 1024;
      g.Bt = (const bf16_t*)(ws + O_W1T) + ((size_t)layer * 5632 + (size_t)pn * 256) * 1024; g.ldb = 1024; g.nt = 16; g.ksplit = 16;
    } else if (kind == G_FFN2) {
      tile_map(L, 256, 4, pm, pn);
      g.A = (const bf16_t*)(ws + O_HDN) + (size_t)pm * 256 * DFF; g.lda = DFF;
      g.Bt = (const bf16_t*)(ws + O_W2T) + ((size_t)layer * 1024 + (size_t)pn * 256) * DFF; g.ldb = DFF; g.nt = 44; g.ksplit = 44;
    } else if (kind == G_GLU) {
      tile_map(L, 256, 4, pm, pn);
      g.A = (const bf16_t*)(ws + O_YB) + (size_t)pm * 256 * 1024; g.lda = 1024;
      g.Bt = (const bf16_t*)(ws + O_WGT) + ((size_t)j2 * 1024 + (size_t)pn * 256) * 1024; g.ldb = 1024; g.nt = 16; g.ksplit = 16;
    } else if (kind == G_POOL) {
      tile_map(L, 256, 4, pm, pn);
      g.A = (const bf16_t*)(ws + O_YB) + (size_t)pm * 256 * 1024 + 256 * pn; g.lda = 1024;
      g.Bt = (const bf16_t*)(ws + O_WPT) + ((size_t)j2 * 4 + pn) * 256 * 256; g.ldb = 256; g.nt = 4; g.ksplit = 4;
    } else if (kind == G_S) {
      grp = L >> 4; pm = L & 15;
      g.A = (const bf16_t*)(ws + O_HB) + ((size_t)grp * NCR + (size_t)pm * 256) * 512; g.lda = 512;
      g.Bt = (const bf16_t*)(ws + O_FBD) + ((size_t)j2 * 32 + grp) * 256 * 512; g.ldb = 512; g.nt = 8; g.ksplit = 8;
    } else {
      grp = L >> 4; pm = L & 15;
      const int gp = grp >> 1, gl = grp & 1;
      g.A = (const bf16_t*)(ws + O_HB) + ((size_t)gp * NCR + (size_t)pm * 256) * 512 + gl * 256; g.lda = 512;
      g.A2 = (const bf16_t*)(ws + O_HST) + ((size_t)gp * NCR + (size_t)pm * 256) * 256 + gl * 128; g.lda2 = 256;
      g.Bt = (const bf16_t*)(ws + O_ME) + ((size_t)j2 * 64 + grp) * 256 * 384; g.ldb = 384; g.nt = 6; g.ksplit = 4;
    }
    f32x4 acc[2][2][4][2];
    gemm_kloop(g, acc, tid);
    int tid2; asm volatile("v_mbcnt_lo_u32_b32 %0, -1, 0\n\tv_mbcnt_hi_u32_b32 %0, -1, %0" : "=v"(tid2)); tid2 |= (wv << 6);
    asm volatile("" : "+s"(pm), "+s"(pn), "+s"(grp)); unsigned char* ws2 = p.ws; asm volatile("" : "+s"(ws2));
    const int wid = tid2 >> 6, lane = tid2 & 63, wr = wid >> 2, wc = wid & 3, fr = lane & 15, fq = lane >> 4;
    const int lc0 = wc * 32 + 8 * fq;
    if (kind == G_FFN1) {
      __syncthreads();
      float* gs = (float*)smem;
#pragma unroll
      for (int ai = 0; ai < 2; ++ai)
#pragma unroll
        for (int m = 0; m < 4; ++m) {
          const int r = ai * 128 + wr * 64 + m * 16 + fr;
          *(f32x4*)(gs + r * 132 + lc0) = acc[ai][0][m][0];
          *(f32x4*)(gs + r * 132 + lc0 + 4) = acc[ai][0][m][1];
        }
      __syncthreads();
      const int fcol = 128 * pn + lc0;
      const float* cw = p.convw + (size_t)layer * 3 * DFF + fcol;
      const f32x4 w0a = *(const f32x4*)(cw), w0b = *(const f32x4*)(cw + 4), w1a = *(const f32x4*)(cw + DFF), w1b = *(const f32x4*)(cw + DFF + 4),
                  w2a = *(const f32x4*)(cw + 2 * DFF), w2b = *(const f32x4*)(cw + 2 * DFF + 4);
      const float* cbp = p.convb + (size_t)layer * DFF + fcol;
      const f32x4 cba = *(const f32x4*)(cbp), cbb = *(const f32x4*)(cbp + 4);
      bf16_t* hdn = (bf16_t*)(ws2 + O_HDN);
      float* gtail = (float*)(ws2 + O_GTAIL); float* ghead = (float*)(ws2 + O_GHEAD); float* vhead = (float*)(ws2 + O_VHEAD);
#pragma unroll
      for (int ai = 0; ai < 2; ++ai)
#pragma unroll
        for (int m = 0; m < 4; ++m) {
          const int r = ai * 128 + wr * 64 + m * 16 + fr;
          const f32x4 g0a = acc[ai][0][m][0], g0b = acc[ai][0][m][1], va = acc[ai][1][m][0], vb = acc[ai][1][m][1];
          if (r >= 2) {
            const f32x4 g1a = *(const f32x4*)(gs + (r - 1) * 132 + lc0), g1b = *(const f32x4*)(gs + (r - 1) * 132 + lc0 + 4);
            const f32x4 g2a = *(const f32x4*)(gs + (r - 2) * 132 + lc0), g2b = *(const f32x4*)(gs + (r - 2) * 132 + lc0 + 4);
            const f32x4 ca = cba + w0a * g2a + w1a * g1a + w2a * g0a, cb = cbb + w0b * g2b + w1b * g1b + w2b * g0b;
            u32x4 o;
            o.x = pk2(gelu_f(ca.x) * va.x, gelu_f(ca.y) * va.y); o.y = pk2(gelu_f(ca.z) * va.z, gelu_f(ca.w) * va.w);
            o.z = pk2(gelu_f(cb.x) * vb.x, gelu_f(cb.y) * vb.y); o.w = pk2(gelu_f(cb.z) * vb.z, gelu_f(cb.w) * vb.w);
            *(u32x4*)(hdn + ((size_t)pm * 256 + r) * DFF + fcol) = o;
          } else {
            float* gh = ghead + ((size_t)pm * 2 + r) * DFF + fcol; float* vh = vhead + ((size_t)pm * 2 + r) * DFF + fcol;
            *(f32x4*)gh = g0a; *(f32x4*)(gh + 4) = g0b; *(f32x4*)vh = va; *(f32x4*)(vh + 4) = vb;
          }
          if (r >= 254) { float* gt = gtail + ((size_t)pm * 2 + (r - 254)) * DFF + fcol; *(f32x4*)gt = g0a; *(f32x4*)(gt + 4) = g0b; }
        }
    } else if (kind == G_FFN2 || kind == G_GLU || kind == G_POOL) {
      bf16_t* mb = (bf16_t*)(ws2 + O_MB);
      float* rss = (float*)(ws2 + O_RSS) + (size_t)(pn * 4 + wc) * NTOK;
      const bf16_t* yb = (const bf16_t*)(ws2 + O_YB);
#pragma unroll
      for (int ai = 0; ai < 2; ++ai)
#pragma unroll
        for (int m = 0; m < 4; ++m) {
          const size_t row = (size_t)pm * 256 + ai * 128 + wr * 64 + m * 16 + fr;
          float ss = 0.f;
#pragma unroll
          for (int bj = 0; bj < 2; ++bj) {
            const int col = 256 * pn + 128 * bj + lc0;
            f32x4 va = acc[ai][bj][m][0], vb = acc[ai][bj][m][1];
            if (kind == G_GLU) {
              const float* bg = p.bglu + (size_t)j2 * DM + col;
              const f32x4 ba = *(const f32x4*)bg, bb = *(const f32x4*)(bg + 4);
              const u32x4 y = *(const u32x4*)(yb + row * DM + col);
              va.x = bf_lo(y.x) * sigmoid_f(va.x + ba.x); va.y = bf_hi(y.x) * sigmoid_f(va.y + ba.y);
              va.z = bf_lo(y.y) * sigmoid_f(va.z + ba.z); va.w = bf_hi(y.y) * sigmoid_f(va.w + ba.w);
              vb.x = bf_lo(y.z) * sigmoid_f(vb.x + bb.x); vb.y = bf_hi(y.z) * sigmoid_f(vb.y + bb.y);
              vb.z = bf_lo(y.w) * sigmoid_f(vb.z + bb.z); vb.w = bf_hi(y.w) * sigmoid_f(vb.w + bb.w);
            } else if (kind == G_POOL) {
              const float* sc = p.pscale + (size_t)j2 * DM + col;
              va = va * *(const f32x4*)sc; vb = vb * *(const f32x4*)(sc + 4);
            }
            ss += va.x * va.x + va.y * va.y + va.z * va.z + va.w * va.w + vb.x * vb.x + vb.y * vb.y + vb.z * vb.z + vb.w * vb.w;
            u32x4 o; o.x = pk2(va.x, va.y); o.y = pk2(va.z, va.w); o.z = pk2(vb.x, vb.y); o.w = pk2(vb.z, vb.w);
            *(u32x4*)(mb + row * DM + col) = o;
          }
          ss += __shfl_xor(ss, 16); ss += __shfl_xor(ss, 32);
          if (fq == 0) rss[row] = ss;
        }
    } else if (kind == G_S) {
      float* S = (float*)(ws2 + O_S) + ((size_t)grp * NCR + (size_t)pm * 256) * 256;
#pragma unroll
      for (int ai = 0; ai < 2; ++ai)
#pragma unroll
        for (int m = 0; m < 4; ++m) {
          const int r = ai * 128 + wr * 64 + m * 16 + fr;
#pragma unroll
          for (int bj = 0; bj < 2; ++bj) {
            float* d = S + (size_t)r * 256 + 128 * bj + lc0;
            *(f32x4*)d = acc[ai][bj][m][0]; *(f32x4*)(d + 4) = acc[ai][bj][m][1];
          }
        }
    } else {
      bf16_t* yb = (bf16_t*)(ws2 + O_YB);
#pragma unroll
      for (int ai = 0; ai < 2; ++ai)
#pragma unroll
        for (int m = 0; m < 4; ++m) {
          const size_t cr = (size_t)pm * 256 + ai * 128 + wr * 64 + m * 16 + fr;
#pragma unroll
          for (int bj = 0; bj < 2; ++bj) {
            const int lc = 128 * bj + lc0, t = lc >> 4, i0 = lc & 15;
            const f32x4 va = acc[ai][bj][m][0], vb = acc[ai][bj][m][1];
            u32x4 o; o.x = pk2(gelu_f(va.x), gelu_f(va.y)); o.y = pk2(gelu_f(va.z), gelu_f(va.w));
            o.z = pk2(gelu_f(vb.x), gelu_f(vb.y)); o.w = pk2(gelu_f(vb.z), gelu_f(vb.w));
            *(u32x4*)(yb + (cr * 16 + t) * DM + 16 * grp + i0) = o;
          }
        }
    }
    __syncthreads();
  }
}

__device__ __forceinline__ void fixup_phase(const Params& p, const int wv, int layer) {
  PHASE_IDS();
  const float* gtail = (const float*)(ws + O_GTAIL); const float* ghead = (const float*)(ws + O_GHEAD); const float* vhead = (const float*)(ws + O_VHEAD);
  bf16_t* hdn = (bf16_t*)(ws + O_HDN);
  const int total = 256 * 2 * (DFF / 4);
  for (int e = bid * 512 + tid; e < total; e += nblk * 512) {
    const int c4 = e % (DFF / 4), pr = e / (DFF / 4), r = pr & 1, pm = pr >> 1, col = c4 * 4;
    const f32x4 z = {0.f, 0.f, 0.f, 0.f};
    const bool first = (pm & 7) == 0;
    const f32x4 t0 = first ? z : *(const f32x4*)(gtail + ((size_t)(pm - 1) * 2 + 0) * DFF + col);
    const f32x4 t1 = first ? z : *(const f32x4*)(gtail + ((size_t)(pm - 1) * 2 + 1) * DFF + col);
    const f32x4 h0 = *(const f32x4*)(ghead + ((size_t)pm * 2 + 0) * DFF + col);
    const f32x4 h1 = *(const f32x4*)(ghead + ((size_t)pm * 2 + 1) * DFF + col);
    const f32x4 v = *(const f32x4*)(vhead + ((size_t)pm * 2 + r) * DFF + col);
    const f32x4 g0 = r ? h1 : h0, g1 = r ? h0 : t1, g2 = r ? t1 : t0;
    const float* cw = p.convw + (size_t)layer * 3 * DFF + col;
    const f32x4 c = *(const f32x4*)(p.convb + (size_t)layer * DFF + col) + *(const f32x4*)cw * g2 + *(const f32x4*)(cw + DFF) * g1 + *(const f32x4*)(cw + 2 * DFF) * g0;
    u32x2 o; o.x = pk2(gelu_f(c.x) * v.x, gelu_f(c.y) * v.y); o.y = pk2(gelu_f(c.z) * v.z, gelu_f(c.w) * v.w);
    *(u32x2*)(hdn + ((size_t)pm * 256 + r) * DFF + col) = o;
  }
}

__device__ __forceinline__ void rowpass_phase(const Params& p, const int wv, const float* xin, bool has_m, const float* gpost, const float* gpre, int layout) {
  PHASE_IDS();
  const int wid = tid >> 6, lane = tid & 63;
  const bf16_t* mb = (const bf16_t*)(ws + O_MB); const float* rss = (const float*)(ws + O_RSS);
  bf16_t* hb = (bf16_t*)(ws + O_HB);
  bf16_t* stg = (bf16_t*)smem;
  for (int cr = bid; cr < NCR; cr += nblk) {
#pragma unroll
    for (int rr = 0; rr < 2; ++rr) {
      const int tl = 2 * wid + rr; const size_t tok = (size_t)cr * 16 + tl;
      f32x4 xv[4];
#pragma unroll
      for (int q = 0; q < 4; ++q) xv[q] = *(const f32x4*)(xin + tok * DM + 256 * q + 4 * lane);
      if (has_m) {
        float ss = 0.f;
#pragma unroll
        for (int s = 0; s < 16; ++s) ss += rss[(size_t)s * NTOK + tok];
        const float rs = rsqrtf(ss * (1.0f / DM) + RMS_EPS);
#pragma unroll
        for (int q = 0; q < 4; ++q) {
          const u32x2 mv = *(const u32x2*)(mb + tok * DM + 256 * q + 4 * lane);
          const f32x4 gp = *(const f32x4*)(gpost + 256 * q + 4 * lane);
          xv[q].x += bf_lo(mv.x) * rs * gp.x; xv[q].y += bf_hi(mv.x) * rs * gp.y; xv[q].z += bf_lo(mv.y) * rs * gp.z; xv[q].w += bf_hi(mv.y) * rs * gp.w;
        }
      }
#pragma unroll
      for (int q = 0; q < 4; ++q) *(f32x4*)(p.out + tok * DM + 256 * q + 4 * lane) = xv[q];
      if (layout != 0) {
        float s2 = 0.f;
#pragma unroll
        for (int q = 0; q < 4; ++q) s2 += xv[q].x * xv[q].x + xv[q].y * xv[q].y + xv[q].z * xv[q].z + xv[q].w * xv[q].w;
        const float rs2 = rsqrtf(wave_sum(s2) * (1.0f / DM) + RMS_EPS);
#pragma unroll
        for (int q = 0; q < 4; ++q) {
          const f32x4 gq = *(const f32x4*)(gpre + 256 * q + 4 * lane);
          u32x2 o; o.x = pk2(xv[q].x * rs2 * gq.x, xv[q].y * rs2 * gq.y); o.y = pk2(xv[q].z * rs2 * gq.z, xv[q].w * rs2 * gq.w);
          if (layout == 1) *(u32x2*)(hb + tok * DM + 256 * q + 4 * lane) = o;
          else *(u32x2*)(stg + tl * 1024 + 256 * q + 4 * lane) = o;
        }
      }
    }
    if (layout == 2) {
      __syncthreads();
#pragma unroll
      for (int ps = 0; ps < 4; ++ps) {
        const int e = (ps * 512 + tid) * 8, gp = e >> 9, within = e & 511, gl = within >> 8, t = (within & 255) >> 4, i0 = within & 15;
        const u32x4 v = *(const u32x4*)(stg + t * 1024 + gp * 32 + gl * 16 + i0);
        *(u32x4*)(hb + ((size_t)gp * NCR + cr) * 512 + within) = v;
      }
      __syncthreads();
    }
  }
}

__device__ __forceinline__ void poolprep_phase(const Params& p, const int wv) {
  PHASE_IDS();
  const bf16_t* hb = (const bf16_t*)(ws + O_HB); bf16_t* yb = (bf16_t*)(ws + O_YB);
  const int oct = tid & 127, sub = tid >> 7;
  const int win = 2 << (oct >> 5);
  const float inv_win = 1.0f / (float)win;
  for (int it = bid; it < NB * 32; it += nblk) {
    const int b = it >> 5, seg = it & 31, t0 = seg * 64 + sub * 16;
    const bf16_t* base = hb + (size_t)b * SEQ * DM + oct * 8;
    float sum[8];
#pragma unroll
    for (int u = 0; u < 8; ++u) sum[u] = 0.f;
    for (int k = 1; k < win; ++k) {
      const int tt = t0 - k;
      if (tt >= 0) {
        const u32x4 v = *(const u32x4*)(base + (size_t)tt * DM);
        sum[0] += bf_lo(v.x); sum[1] += bf_hi(v.x); sum[2] += bf_lo(v.y); sum[3] += bf_hi(v.y);
        sum[4] += bf_lo(v.z); sum[5] += bf_hi(v.z); sum[6] += bf_lo(v.w); sum[7] += bf_hi(v.w);
      }
    }
    for (int t = t0; t < t0 + 16; ++t) {
      const u32x4 v = *(const u32x4*)(base + (size_t)t * DM);
      const float c0 = bf_lo(v.x), c1 = bf_hi(v.x), c2 = bf_lo(v.y), c3 = bf_hi(v.y), c4 = bf_lo(v.z), c5 = bf_hi(v.z), c6 = bf_lo(v.w), c7 = bf_hi(v.w);
      const float ic = (t + 1 >= win) ? inv_win : 1.0f / (float)(t + 1);
      sum[0] += c0; sum[1] += c1; sum[2] += c2; sum[3] += c3; sum[4] += c4; sum[5] += c5; sum[6] += c6; sum[7] += c7;
      u32x4 o; o.x = pk2(sum[0] * ic - c0, sum[1] * ic - c1); o.y = pk2(sum[2] * ic - c2, sum[3] * ic - c3);
      o.z = pk2(sum[4] * ic - c4, sum[5] * ic - c5); o.w = pk2(sum[6] * ic - c6, sum[7] * ic - c7);
      *(u32x4*)(yb + ((size_t)b * SEQ + t) * DM + oct * 8) = o;
      const int old = t - win + 1;
      if (old >= 0) {
        const u32x4 w = *(const u32x4*)(base + (size_t)old * DM);
        sum[0] -= bf_lo(w.x); sum[1] -= bf_hi(w.x); sum[2] -= bf_lo(w.y); sum[3] -= bf_hi(w.y);
        sum[4] -= bf_lo(w.z); sum[5] -= bf_hi(w.z); sum[6] -= bf_lo(w.w); sum[7] -= bf_hi(w.w);
      }
    }
  }
}

__device__ __forceinline__ void scan_phase(const Params& p, const int wv, int j2) {
  PHASE_IDS();
  const float* S = (const float*)(ws + O_S); bf16_t* H = (bf16_t*)(ws + O_HST);
  const float* AT = (const float*)(ws + O_AT) + (size_t)j2 * 64 * 64 * 2;
  for (int idx = bid * 512 + tid; idx < 32 * NB * 128; idx += nblk * 512) {
    const int gp = idx >> 12, rem = idx & 4095, b = rem >> 7, q = rem & 127, gl = q >> 6, pp = q & 63;
    const int g = 2 * gp + gl;
    const float ar = AT[(g * 64 + pp) * 2], ai = AT[(g * 64 + pp) * 2 + 1];
    float hr = 0.f, hi = 0.f;
    const size_t base = ((size_t)gp * NCR + (size_t)b * 128) * 256 + gl * 128 + pp;
#pragma unroll 8
    for (int c = 0; c < 128; ++c) {
      const size_t off = base + (size_t)c * 256;
      const float sr = S[off], si = S[off + 64];
      H[off] = (bf16_t)(pk2(hr, hr) & 0xffffu); H[off + 64] = (bf16_t)(pk2(hi, hi) & 0xffffu);
      const float nr = ar * hr - ai * hi + sr, ni = ar * hi + ai * hr + si;
      hr = nr; hi = ni;
    }
  }
}

__device__ __forceinline__ void transpose_item(const float* W, int ldw, int k0, int c0, bf16_t* dst, int ldd, float* scr, int lane) {
#pragma unroll 8
  for (int i = 0; i < 32; ++i) { const int kk = 2 * i + (lane >> 5); scr[kk * 33 + (lane & 31)] = W[(size_t)(k0 + kk) * ldw + c0 + (lane & 31)]; }
  asm volatile("s_waitcnt lgkmcnt(0)" ::: "memory");
  const int c = lane & 7;
#pragma unroll
  for (int jj = 0; jj < 4; ++jj) {
    const int n = (lane >> 3) + 8 * jj; const float* s = scr + (8 * c) * 33 + perm32(n);
    u32x4 o; o.x = pk2(s[0 * 33], s[1 * 33]); o.y = pk2(s[2 * 33], s[3 * 33]); o.z = pk2(s[4 * 33], s[5 * 33]); o.w = pk2(s[6 * 33], s[7 * 33]);
    *(u32x4*)(dst + (size_t)n * ldd + 8 * c) = o;
  }
  asm volatile("s_waitcnt lgkmcnt(0)" ::: "memory");
}

__device__ __forceinline__ void prep_phase(const Params& p, const int wv) {
  PHASE_IDS();
  const int wid = tid >> 6, lane = tid & 63;
  float* lf = (float*)smem;
  float* apr = lf;
  float* api = apr + 17 * 64;
  float* Bbr = api + 17 * 64;
  float* Bbi = Bbr + 1024;
  float* Cr = Bbi + 1024;
  float* Ci = Cr + 1024;
  float* Kk = Ci + 1024;
  float* fre = Kk + 4096;
  float* fim = fre + 64;
  for (int it = bid; it < 128; it += nblk) {
    const int j = it >> 6, g = it & 63, gp = g >> 1, gl = g & 1;
    if (tid < 64) {
      const int pp = tid;
      const float lr = p.lam_re[(j * 64 + g) * 64 + pp], li = p.lam_im[(j * 64 + g) * 64 + pp];
      const float dt = expf(p.log_dt[j * 64 + g]);
      const float mag = expf(lr * dt);
      float sn, cs; sincosf(li * dt, &sn, &cs);
      const float ar = mag * cs, ai = mag * sn;
      const float den = lr * lr + li * li, nr = ar - 1.0f, ni = ai;
      fre[pp] = (nr * lr + ni * li) / den; fim[pp] = (ni * lr - nr * li) / den;
      float pr = 1.0f, pi = 0.0f;
      for (int k = 0; k <= 16; ++k) { apr[k * 64 + pp] = pr; api[k * 64 + pp] = pi; const float t = pr * ar - pi * ai; pi = pr * ai + pi * ar; pr = t; }
      float* AT = (float*)(ws + O_AT) + ((size_t)(j * 64 + g) * 64 + pp) * 2;
      AT[0] = apr[16 * 64 + pp]; AT[1] = api[16 * 64 + pp];
    }
    __syncthreads();
    for (int e = tid; e < 1024; e += 512) {
      const int pp = e >> 4;
      const float br = p.b_re[(size_t)(j * 64 + g) * 1024 + e], bi = p.b_im[(size_t)(j * 64 + g) * 1024 + e];
      Bbr[e] = fre[pp] * br - fim[pp] * bi; Bbi[e] = fre[pp] * bi + fim[pp] * br;
      Cr[e] = p.c_re[(size_t)(j * 64 + g) * 1024 + e]; Ci[e] = p.c_im[(size_t)(j * 64 + g) * 1024 + e];
    }
    __syncthreads();
    for (int e = tid; e < 4096; e += 512) {
      const int k = e >> 8, i = (e >> 4) & 15, jj = e & 15;
      float a = 0.f;
      for (int pp = 0; pp < 64; ++pp) {
        const float wr_ = apr[k * 64 + pp] * Bbr[pp * 16 + jj] - api[k * 64 + pp] * Bbi[pp * 16 + jj];
        const float wi_ = apr[k * 64 + pp] * Bbi[pp * 16 + jj] + api[k * 64 + pp] * Bbr[pp * 16 + jj];
        a += Cr[i * 64 + pp] * wr_ - Ci[i * 64 + pp] * wi_;
      }
      if (k == 0 && i == jj) a += p.s5d[(size_t)j * DM + 16 * g + i];
      Kk[e] = a;
    }
    __syncthreads();
    bf16_t* ME = (bf16_t*)(ws + O_ME) + ((size_t)j * 64 + g) * 256 * 384;
    for (int v = tid; v < 256 * 48; v += 512) {
      const int R = v / 48, kc0 = (v % 48) * 8, lr_ = slot2col(R), t = lr_ >> 4, i = lr_ & 15;
      float val[8];
#pragma unroll
      for (int u = 0; u < 8; ++u) {
        const int kc = kc0 + u;
        if (kc < 256) { const int s = kc >> 4, jj = kc & 15; val[u] = (s <= t) ? Kk[((t - s) * 16 + i) * 16 + jj] : 0.f; }
        else {
          const int q = kc - 256, pp = q & 63;
          const float alr = apr[(t + 1) * 64 + pp], ali = api[(t + 1) * 64 + pp];
          val[u] = (q < 64) ? (Cr[i * 64 + pp] * alr - Ci[i * 64 + pp] * ali) : (-Cr[i * 64 + pp] * ali - Ci[i * 64 + pp] * alr);
        }
      }
      u32x4 o; o.x = pk2(val[0], val[1]); o.y = pk2(val[2], val[3]); o.z = pk2(val[4], val[5]); o.w = pk2(val[6], val[7]);
      *(u32x4*)(ME + (size_t)R * 384 + kc0) = o;
    }
    bf16_t* FB = (bf16_t*)(ws + O_FBD) + ((size_t)j * 32 + gp) * 256 * 512;
    for (int v = tid; v < 128 * 64; v += 512) {
      const int R = gl * 128 + (v >> 6), kc0 = (v & 63) * 8, lr_ = slot2col(R), q = lr_ & 127, pp = q & 63;
      u32x4 o = {0u, 0u, 0u, 0u};
      if ((kc0 >> 8) == gl) {
        const int s = (kc0 & 255) >> 4, j0 = kc0 & 15;
        const float alr = apr[(15 - s) * 64 + pp], ali = api[(15 - s) * 64 + pp];
        float val[8];
#pragma unroll
        for (int u = 0; u < 8; ++u) {
          const float br = Bbr[pp * 16 + j0 + u], bi = Bbi[pp * 16 + j0 + u];
          val[u] = (q < 64) ? (alr * br - ali * bi) : (alr * bi + ali * br);
        }
        o.x = pk2(val[0], val[1]); o.y = pk2(val[2], val[3]); o.z = pk2(val[4], val[5]); o.w = pk2(val[6], val[7]);
      }
      *(u32x4*)(FB + (size_t)R * 512 + kc0) = o;
    }
    __syncthreads();
  }
  __syncthreads();
  float* scr = (float*)smem + wid * (64 * 33);
  const int gw = bid * 8 + wid, ngw = nblk * 8;
  constexpr int I_W1 = 16 * 176, I_W2 = 44 * 32, I_WG = 16 * 32, I_WP = 4 * 8;
  constexpr int NITEMS = 4 * I_W1 + 4 * I_W2 + 2 * I_WG + 8 * I_WP;
  for (int it = gw; it < NITEMS; it += ngw) {
    int r = it;
    if (r < 4 * I_W1) {
      const int layer = r / I_W1, q = r % I_W1, kb = q / 176, nb = q % 176, n0 = nb * 32, jt = n0 >> 8, l0 = n0 & 255;
      const float* W = (l0 < 128 ? p.wgate : p.wval) + (size_t)layer * DM * DFF;
      transpose_item(W, DFF, kb * 64, 128 * jt + (l0 & 127), (bf16_t*)(ws + O_W1T) + ((size_t)layer * 5632 + n0) * 1024 + kb * 64, 1024, scr, lane);
      continue;
    }
    r -= 4 * I_W1;
    if (r < 4 * I_W2) {
      const int layer = r / I_W2, q = r % I_W2, kb = q / 32, nb = q % 32;
      transpose_item(p.wdown + (size_t)layer * DFF * DM, DM, kb * 64, nb * 32, (bf16_t*)(ws + O_W2T) + ((size_t)layer * 1024 + nb * 32) * DFF + kb * 64, DFF, scr, lane);
      continue;
    }
    r -= 4 * I_W2;
    if (r < 2 * I_WG) {
      const int j = r / I_WG, q = r % I_WG, kb = q / 32, nb = q % 32;
      transpose_item(p.wglu + (size_t)j * DM * DM, DM, kb * 64, nb * 32, (bf16_t*)(ws + O_WGT) + ((size_t)j * 1024 + nb * 32) * 1024 + kb * 64, 1024, scr, lane);
      continue;
    }
    r -= 2 * I_WG;
    { const int jg = r / I_WP, q = r % I_WP, kb = q / 8, nb = q % 8;
      transpose_item(p.poolw + (size_t)jg * 256 * 256, 256, kb * 64, nb * 32, (bf16_t*)(ws + O_WPT) + ((size_t)jg * 256 + nb * 32) * 256 + kb * 64, 256, scr, lane); }
  }
  __syncthreads();
}

__global__ void __launch_bounds__(512, 2) mega(Params p) {
  cg::grid_group grid = cg::this_grid();
  const int wv = __builtin_amdgcn_readfirstlane((int)(threadIdx.x >> 6));
  prep_phase(p, wv);
  rowpass_phase(p, wv, p.x, false, nullptr, p.n_mix_pre, 2);
  grid.sync();
  for (int i = 0; i < DEPTH; ++i) {
    if ((i & 1) == 0) {
      gemm_phase(p, wv, G_S, i); grid.sync();
      scan_phase(p, wv, i >> 1); grid.sync();
      gemm_phase(p, wv, G_Y, i); grid.sync();
      gemm_phase(p, wv, G_GLU, i); grid.sync();
    } else {
      poolprep_phase(p, wv); grid.sync();
      gemm_phase(p, wv, G_POOL, i); grid.sync();
    }
    rowpass_phase(p, wv, p.out, true, p.n_mix_post + i * DM, p.n_ffn_pre + i * DM, 1); grid.sync();
    gemm_phase(p, wv, G_FFN1, i); grid.sync();
    fixup_phase(p, wv, i); grid.sync();
    gemm_phase(p, wv, G_FFN2, i); grid.sync();
    if (i < DEPTH - 1) { rowpass_phase(p, wv, p.out, true, p.n_ffn_post + i * DM, p.n_mix_pre + (i + 1) * DM, ((i + 1) & 1) ? 1 : 2); grid.sync(); }
    else rowpass_phase(p, wv, p.out, true, p.n_ffn_post + i * DM, nullptr, 0);
  }
}

extern "C" void kernel_launch(void* const* d_in, const int* in_sizes, int n_in, void* d_out, int out_size, void* d_ws, size_t ws_size, hipStream_t stream) {
  static int grid_blocks = 0;
  if (!grid_blocks) {
    if (n_in != 22 || out_size != NTOK * DM || ws_size < WS_END) {
      fprintf(stderr, "kernel_launch: unexpected shapes (n_in %d out %d ws %zu need %zu)\n", n_in, out_size, ws_size, (size_t)WS_END);
      grid_blocks = -1; return;
    }
    int dev = 0, cus = 0, per_cu = 0;
    (void)hipGetDevice(&dev);
    (void)hipDeviceGetAttribute(&cus, hipDeviceAttributeMultiprocessorCount, dev);
    (void)hipFuncSetAttribute((const void*)mega, hipFuncAttributeMaxDynamicSharedMemorySize, LDS_BYTES);
    (void)hipOccupancyMaxActiveBlocksPerMultiprocessor(&per_cu, (const void*)mega, 512, LDS_BYTES);
    if (per_cu < 1) fprintf(stderr, "kernel_launch: occupancy query says %d blocks/CU\n", per_cu);
    grid_blocks = cus;
  }
  if (grid_blocks < 0) return;
  Params p{};
  const float** f = (const float**)&p;
  for (int i = 0; i < 22; ++i) f[i] = (const float*)d_in[i];
  p.out = (float*)d_out; p.ws = (unsigned char*)d_ws;
  void* args[] = {&p};
  hipError_t e = hipLaunchCooperativeKernel((void*)mega, dim3(grid_blocks), dim3(512), args, LDS_BYTES, stream);
  if (e != hipSuccess) fprintf(stderr, "cooperative launch failed: %s (grid %d)\n", hipGetErrorString(e), grid_blocks);
}
```

```cpp
#include <hip/hip_runtime.h>
#include <hip/hip_cooperative_groups.h>
#include <cstdio>
namespace cg = cooperative_groups;

typedef unsigned short bf16_t;
typedef short bf16x8 __attribute__((ext_vector_type(8)));
typedef float f32x4 __attribute__((ext_vector_type(4)));
typedef unsigned u32x4 __attribute__((ext_vector_type(4)));
typedef unsigned u32x2 __attribute__((ext_vector_type(2)));

constexpr int DM = 1024, NB = 32, SEQ = 2048, NTOK = NB * SEQ, DFF = 2816, DEPTH = 4;
constexpr int NCR = NTOK / 16;
constexpr float RMS_EPS = 1e-6f;

constexpr size_t SZ_W1T = (size_t)4 * 5632 * 1024 * 2, SZ_W2T = (size_t)4 * 1024 * 2816 * 2, SZ_WGT = (size_t)2 * 1024 * 1024 * 2,
                 SZ_WPT = (size_t)2 * 4 * 256 * 256 * 2, SZ_FBD = (size_t)2 * 32 * 256 * 512 * 2, SZ_ME = (size_t)2 * 64 * 256 * 384 * 2,
                 SZ_AT = (size_t)2 * 64 * 64 * 2 * 4, SZ_RSS = (size_t)16 * NTOK * 4, SZ_HALO = (size_t)256 * 2 * DFF * 4,
                 SZ_ACT = (size_t)NTOK * DM * 2, SZ_HDN = (size_t)NTOK * DFF * 2;
constexpr size_t O_W1T = 0, O_W2T = O_W1T + SZ_W1T, O_WGT = O_W2T + SZ_W2T, O_WPT = O_WGT + SZ_WGT, O_FBD = O_WPT + SZ_WPT,
                 O_ME = O_FBD + SZ_FBD, O_AT = O_ME + SZ_ME, O_RSS = O_AT + SZ_AT, O_GTAIL = O_RSS + SZ_RSS, O_GHEAD = O_GTAIL + SZ_HALO,
                 O_VHEAD = O_GHEAD + SZ_HALO, O_HB = O_VHEAD + SZ_HALO, O_YB = O_HB + SZ_ACT, O_MB = O_YB + SZ_ACT, O_HDN = O_MB + SZ_ACT,
                 O_CTR = O_HDN + SZ_HDN, O_XB = O_CTR + 16384, O_RS2 = O_XB + SZ_ACT, WS_END = O_RS2 + (size_t)NTOK * 4;
constexpr size_t O_GE = O_YB;
constexpr size_t O_VH = O_YB + (size_t)256 * 4 * 4 * DFF * 4;
static_assert(O_VH + (size_t)256 * 4 * 2 * DFF * 4 <= O_YB + SZ_ACT, "alias");
constexpr size_t O_S = O_HDN;
constexpr size_t O_HST = O_HDN + (size_t)32 * 4096 * 256 * 4;
static_assert(O_HST + (size_t)32 * 4096 * 256 * 2 <= WS_END, "alias");
constexpr int LDS_BYTES = 131072 + 16;

struct Params {
  const float *x, *lam_re, *lam_im, *log_dt, *b_re, *b_im, *c_re, *c_im, *s5d, *wglu, *bglu, *poolw, *pscale, *wgate, *wval, *convw, *convb,
      *wdown, *n_mix_pre, *n_mix_post, *n_ffn_pre, *n_ffn_post;
  float* out;
  unsigned char* ws;
};

extern __shared__ __attribute__((aligned(16))) char smem[];

typedef const __attribute__((address_space(4))) Params* KP;
#define KP_GET(name) KP name = (KP)__builtin_amdgcn_kernarg_segment_ptr(); asm volatile("" : "+s"(name))
#define PHASE_IDS() int tid; asm volatile("v_mbcnt_lo_u32_b32 %0, -1, 0\n\tv_mbcnt_hi_u32_b32 %0, -1, %0" : "=v"(tid)); tid |= (wv << 6); int bid = blockIdx.x; asm volatile("" : "+s"(bid)); KP_GET(kp); unsigned char* ws = kp->ws; const int nblk = gridDim.x; (void)bid; (void)ws; (void)nblk
__device__ __forceinline__ unsigned pk2(float lo, float hi) { unsigned r; asm("v_cvt_pk_bf16_f32 %0, %1, %2" : "=v"(r) : "v"(lo), "v"(hi)); return r; }
__device__ __forceinline__ float bf_lo(unsigned u) { return __uint_as_float(u << 16); }
__device__ __forceinline__ float bf_hi(unsigned u) { return __uint_as_float(u & 0xffff0000u); }
__device__ __forceinline__ float sigmoid_f(float z) { return __builtin_amdgcn_rcpf(1.0f + __builtin_amdgcn_exp2f(-1.4426950408889634f * z)); }
__device__ __forceinline__ float gelu_f(float v) {
  const float p = __builtin_fmaf(v * v, -2.3022081981f * 0.044715f, -2.3022081981f);
  return v * __builtin_amdgcn_rcpf(1.0f + __builtin_amdgcn_exp2f(v * p));
}
__device__ __forceinline__ float wave_sum(float v) {
#pragma unroll
  for (int o = 1; o < 64; o <<= 1) v += __shfl_xor(v, o);
  return v;
}
__device__ __forceinline__ int perm32(int rho) { const int n = rho >> 4, i = rho & 15; return 8 * (i >> 2) + 4 * n + (i & 3); }
__device__ __forceinline__ int slot2col(int R) { return (R & ~31) + perm32(R & 31); }

constexpr int HT = 128 * 64;
__device__ __forceinline__ int lds_byte(int r, int c) {
  int st = (r >> 4) * 2 + (c >> 5), rr = r & 15, cc = c & 31, ob = rr * 64 + cc * 2;
  return st * 1024 + (ob ^ (((ob >> 9) & 1) << 5));
}
struct Unit { const char* A; const char* A2; const char* B; int pm, pn, grp; };
__device__ __forceinline__ float dpp_ror1(float v) { return __int_as_float(__builtin_amdgcn_mov_dpp(__float_as_int(v), 0x121, 0xf, 0xf, false)); }
__device__ __forceinline__ float dpp_ror2(float v) { return __int_as_float(__builtin_amdgcn_mov_dpp(__float_as_int(v), 0x122, 0xf, 0xf, false)); }

template <int WG = 8> __device__ __forceinline__ void tile_map(int L, int nM, int nN, int& pm, int& pn) {
  const int nwg = nM * nN; int wgid = L;
  { const int q = nwg / 8, r = nwg % 8, xcd = wgid % 8, off = wgid / 8; wgid = (xcd < r ? xcd * (q + 1) : r * (q + 1) + (xcd - r) * q) + off; }
  const int nig = WG * nN, gid = wgid / nig, fm = gid * WG, gsz = (nM - fm) < WG ? (nM - fm) : WG;
  pm = fm + ((wgid % nig) % gsz); pn = (wgid % nig) / gsz;
}

enum { G_FFN1 = 0, G_FFN2 = 1, G_GLU = 2, G_POOL = 3, G_S = 4, G_Y = 5 };

__device__ __forceinline__ void gemm_phase(const int wv, const int kind, const int layer) {
  PHASE_IDS();
  const int j2 = layer >> 1;
  int ntiles, nt, ksplit, lda, lda2 = 0, ldb;
  switch (kind) {
    case G_FFN1: ntiles = 256 * 22; nt = 16; lda = 1024; ldb = 1024; break;
    case G_FFN2: ntiles = 1024; nt = 44; lda = DFF; ldb = DFF; break;
    case G_GLU: ntiles = 1024; nt = 16; lda = 1024; ldb = 1024; break;
    case G_POOL: ntiles = 1024; nt = 4; lda = 1024; ldb = 256; break;
    case G_S: ntiles = 512; nt = 8; lda = 512; ldb = 512; break;
    default: ntiles = 1024; nt = 6; lda = 512; lda2 = 256; ldb = 384; break;
  }
  ksplit = (kind == G_Y) ? 4 : nt;
  typedef __attribute__((address_space(3))) unsigned char* LP;
  const LP lds = (LP)smem;
  unsigned voA, voA2, voB, voAh, voA2h, voBh; int aoff, boff;
  {
    const int wid = wv, lane = tid & 63, wr = wid >> 2, wc = wid & 3, fr = lane & 15, fq = lane >> 4;
    const int sb = lane * 16, swz = sb ^ (((sb >> 9) & 1) << 5), s_r = (wid >> 1) * 16 + swz / 64, s_c = (wid & 1) * 32 + (swz % 64) / 2;
    voA = (unsigned)(s_r * lda + s_c) * 2u; voA2 = (unsigned)(s_r * lda2 + s_c) * 2u; voB = (unsigned)(s_r * ldb + s_c) * 2u;
    voAh = voA + 128u * lda; voA2h = voA2 + 128u * lda2; voBh = voB + 128u * ldb;
    aoff = lds_byte(wr * 64 + fr, fq * 8); boff = lds_byte(wc * 32 + fr, fq * 8);
  }
  const int wr_u = wv >> 2;
  const unsigned ldsw = (unsigned)wv * 1024u;
  const unsigned ldsbase = (unsigned)(unsigned long)lds + ldsw;
  auto get_unit = [&](const int L, Unit& u) {
    int pm = 0, pn = 0, grp = 0; u.A2 = nullptr;
    if (kind == G_FFN1) {
      tile_map<4>(L, 256, 22, pm, pn);
      u.A = (const char*)((const bf16_t*)(ws + O_XB) + (size_t)pm * 256 * 1024);
      u.B = (const char*)((const bf16_t*)(ws + O_W1T) + ((size_t)layer * 5632 + (size_t)pn * 256) * 1024);
    } else if (kind == G_FFN2) {
      tile_map<4>(L, 256, 4, pm, pn);
      u.A = (const char*)((const bf16_t*)(ws + O_HDN) + (size_t)pm * 256 * DFF);
      u.B = (const char*)((const bf16_t*)(ws + O_W2T) + ((size_t)layer * 1024 + (size_t)pn * 256) * DFF);
    } else if (kind == G_GLU) {
      tile_map(L, 256, 4, pm, pn);
      u.A = (const char*)((const bf16_t*)(ws + O_YB) + (size_t)pm * 256 * 1024);
      u.B = (const char*)((const bf16_t*)(ws + O_WGT) + ((size_t)j2 * 1024 + (size_t)pn * 256) * 1024);
    } else if (kind == G_POOL) {
      tile_map(L, 256, 4, pm, pn);
      u.A = (const char*)((const bf16_t*)(ws + O_YB) + (size_t)pm * 256 * 1024 + 256 * pn);
      u.B = (const char*)((const bf16_t*)(ws + O_WPT) + ((size_t)j2 * 4 + pn) * 256 * 256);
    } else if (kind == G_S) {
      grp = L >> 4; pm = L & 15;
      u.A = (const char*)((const bf16_t*)(ws + O_HB) + ((size_t)grp * NCR + (size_t)pm * 256) * 512);
      u.B = (const char*)((const bf16_t*)(ws + O_FBD) + ((size_t)j2 * 32 + grp) * 256 * 512);
    } else {
      grp = L >> 4; pm = L & 15;
      const int gp = grp >> 1, gl = grp & 1;
      u.A = (const char*)((const bf16_t*)(ws + O_HB) + ((size_t)gp * NCR + (size_t)pm * 256) * 512 + gl * 256);
      u.A2 = (const char*)((const bf16_t*)(ws + O_HST) + ((size_t)gp * NCR + (size_t)pm * 256) * 256 + gl * 128);
      u.B = (const char*)((const bf16_t*)(ws + O_ME) + ((size_t)j2 * 64 + grp) * 256 * 384);
    }
    u.pm = pm; u.pn = pn; u.grp = grp;
  };
#define BUF_A(b, h) (((b) * 2 + (h)) * 16384)
#define BUF_B(b, h) ((4 + (b) * 2 + (h)) * 16384)
#define GLDS(voff_, sbase_, ldsaddr_) asm volatile("s_mov_b32 m0, %2\n\ts_nop 0\n\tglobal_load_lds_dwordx4 %0, %1" :: "v"(voff_), "s"(sbase_), "s"(ldsaddr_) : "memory", "m0")
#define STAGE_A(bufoff, u, half, kt) do { const char* _sb; unsigned _o, _o2; \
    if (kind != G_Y || (kt) < ksplit) { _sb = (u).A + (size_t)(kt) * 128 + (size_t)(half) * 256 * lda; _o = voA; _o2 = voAh; } \
    else { _sb = (u).A2 + (size_t)((kt) - ksplit) * 128 + (size_t)(half) * 256 * lda2; _o = voA2; _o2 = voA2h; } \
    GLDS(_o, _sb, ldsbase + (unsigned)(bufoff)); GLDS(_o2, _sb, ldsbase + (unsigned)(bufoff) + 8192u); } while (0)
#define STAGE_B(bufoff, u, half, kt) do { const char* _sb = (u).B + (size_t)(kt) * 128 + (size_t)(half) * 256 * ldb; \
    GLDS(voB, _sb, ldsbase + (unsigned)(bufoff)); GLDS(voBh, _sb, ldsbase + (unsigned)(bufoff) + 8192u); } while (0)
#define LDA(dst, b, h) do { _Pragma("unroll") for (int m = 0; m < 4; ++m) _Pragma("unroll") for (int k = 0; k < 2; ++k) \
    dst[m][k] = *(const __attribute__((address_space(3))) bf16x8*)(lds + BUF_A(b, h) + aoff + m * 2048 + k * 1024); } while (0)
#define LDB(dst, b, h) do { _Pragma("unroll") for (int n = 0; n < 2; ++n) _Pragma("unroll") for (int k = 0; k < 2; ++k) \
    dst[n][k] = *(const __attribute__((address_space(3))) bf16x8*)(lds + BUF_B(b, h) + boff + n * 2048 + k * 1024); } while (0)
#define MMA(ai, bj, At_, Bt_) do { __builtin_amdgcn_s_setprio(1); \
    _Pragma("unroll") for (int m = 0; m < 4; ++m) _Pragma("unroll") for (int n = 0; n < 2; ++n) _Pragma("unroll") for (int k = 0; k < 2; ++k) \
      acc[ai][bj][m][n] = __builtin_amdgcn_mfma_f32_16x16x32_bf16(Bt_[n][k], At_[m][k], acc[ai][bj][m][n], 0, 0, 0); \
    __builtin_amdgcn_s_setprio(0); } while (0)
#define MMAZ(ai, bj, At_, Bt_) do { __builtin_amdgcn_s_setprio(1); \
    _Pragma("unroll") for (int m = 0; m < 4; ++m) _Pragma("unroll") for (int n = 0; n < 2; ++n) { \
      acc[ai][bj][m][n] = __builtin_amdgcn_mfma_f32_16x16x32_bf16(Bt_[n][0], At_[m][0], (f32x4){0.f, 0.f, 0.f, 0.f}, 0, 0, 0); \
      acc[ai][bj][m][n] = __builtin_amdgcn_mfma_f32_16x16x32_bf16(Bt_[n][1], At_[m][1], acc[ai][bj][m][n], 0, 0, 0); } \
    __builtin_amdgcn_s_setprio(0); } while (0)
#define WAIT_V(n) asm volatile("s_waitcnt vmcnt(" #n ")" ::: "memory")
#define WAIT_L(n) asm volatile("s_waitcnt lgkmcnt(" #n ")" ::: "memory")
#define BAR __builtin_amdgcn_s_barrier()
#define SCHED __builtin_amdgcn_sched_barrier(0)
#define ZERO_ACC() do { _Pragma("unroll") for (int a = 0; a < 2; ++a) _Pragma("unroll") for (int b = 0; b < 2; ++b) _Pragma("unroll") for (int m = 0; m < 4; ++m) \
    _Pragma("unroll") for (int n = 0; n < 2; ++n) acc[a][b][m][n] = (f32x4){0.f, 0.f, 0.f, 0.f}; } while (0)
  int L = bid;
  if (L >= ntiles) return;
  Unit cur, nxt;
  get_unit(L, cur);
  __builtin_amdgcn_s_waitcnt(0);
  f32x4 acc[2][2][4][2];
  bf16x8 At[4][2], B0[2][2], B1[2][2];
  STAGE_B(BUF_B(0, 0), cur, 0, 0); STAGE_A(BUF_A(0, 0), cur, 0, 0); STAGE_B(BUF_B(0, 1), cur, 1, 0); STAGE_A(BUF_A(0, 1), cur, 1, 0);
  if (wr_u == 1) BAR;
  WAIT_V(4); BAR;
  STAGE_B(BUF_B(1, 0), cur, 0, 1); STAGE_A(BUF_A(1, 0), cur, 0, 1); STAGE_B(BUF_B(1, 1), cur, 1, 1);
  WAIT_V(6); BAR;
  for (;;) {
    const int Ln = L + nblk; const bool has_next = Ln < ntiles;
    if (has_next) get_unit(Ln, nxt); else nxt = cur;
#define KBODY(MM) \
      LDB(B0, 0, 0); SCHED; LDA(At, 0, 0); STAGE_A(BUF_A(1, 1), cur, 1, t + 1); \
      WAIT_L(8); BAR; WAIT_L(0); MM(0, 0, At, B0); BAR; SCHED; \
      LDB(B1, 0, 1); STAGE_B(BUF_B(0, 0), u2, 0, k2); \
      BAR; WAIT_L(0); MM(0, 1, At, B1); BAR; \
      LDA(At, 0, 1); STAGE_A(BUF_A(0, 0), u2, 0, k2); \
      BAR; WAIT_L(0); MM(1, 0, At, B0); BAR; SCHED; \
      STAGE_B(BUF_B(0, 1), u2, 1, k2); \
      WAIT_V(6); BAR; MM(1, 1, At, B1); BAR; \
      LDB(B0, 1, 0); SCHED; LDA(At, 1, 0); STAGE_A(BUF_A(0, 1), u2, 1, k2); \
      WAIT_L(8); BAR; WAIT_L(0); MMA(0, 0, At, B0); BAR; SCHED; \
      LDB(B1, 1, 1); STAGE_B(BUF_B(1, 0), u2, 0, k3); \
      BAR; WAIT_L(0); MMA(0, 1, At, B1); BAR; \
      LDA(At, 1, 1); STAGE_A(BUF_A(1, 0), u2, 0, k3); \
      BAR; WAIT_L(0); MMA(1, 0, At, B0); BAR; SCHED; \
      STAGE_B(BUF_B(1, 1), u2, 1, k3); \
      WAIT_V(6); BAR; MMA(1, 1, At, B1); BAR;
    {
      const int t = 0, k2 = 2, k3 = 3; const Unit u2 = cur;
      KBODY(MMAZ)
    }
    int t_s = 2; asm volatile("" : "+s"(t_s));
    for (int t = t_s; t < nt; t += 2) {
      const bool last = (t == nt - 2);
      Unit u2 = cur; if (last) u2 = nxt;
      const int k2 = last ? 0 : t + 2, k3 = k2 + 1;
      KBODY(MMA)
    }
#undef KBODY
    {
      int tid2; asm volatile("v_mbcnt_lo_u32_b32 %0, -1, 0\n\tv_mbcnt_hi_u32_b32 %0, -1, %0" : "=v"(tid2)); tid2 |= (wv << 6);
      int pm = cur.pm, pn = cur.pn, grp = cur.grp;
      asm volatile("" : "+s"(pm), "+s"(pn), "+s"(grp)); KP_GET(kp2); unsigned char* ws2 = kp2->ws;
      const int wid = tid2 >> 6, lane = tid2 & 63, wr = wid >> 2, wc = wid & 3, fr = lane & 15, fq = lane >> 4;
      const int lc0 = wc * 32 + 8 * fq;
      if (kind == G_FFN1) {
        const int fcol = 128 * pn + lc0;
        const float* cw = kp2->convw + (size_t)layer * 3 * DFF + fcol;
        f32x4 w0[2], w1[2], w2[2], cb[2];
        w0[0] = *(const f32x4*)(cw); w0[1] = *(const f32x4*)(cw + 4); w1[0] = *(const f32x4*)(cw + DFF); w1[1] = *(const f32x4*)(cw + DFF + 4);
        w2[0] = *(const f32x4*)(cw + 2 * DFF); w2[1] = *(const f32x4*)(cw + 2 * DFF + 4);
        const float* cbp = kp2->convb + (size_t)layer * DFF + fcol;
        cb[0] = *(const f32x4*)(cbp); cb[1] = *(const f32x4*)(cbp + 4);
        bf16_t* hdn = (bf16_t*)(ws2 + O_HDN);
        float* ge = (float*)(ws2 + O_GE); float* vh = (float*)(ws2 + O_VH);
        {
          const float* rs2b = (const float*)(ws2 + O_RS2) + (size_t)pm * 256 + wr * 64 + fr;
          float rsr[2][4];
#pragma unroll
          for (int ai = 0; ai < 2; ++ai)
#pragma unroll
            for (int m = 0; m < 4; ++m) rsr[ai][m] = rs2b[ai * 128 + m * 16];
#pragma unroll
          for (int ai = 0; ai < 2; ++ai)
#pragma unroll
            for (int m = 0; m < 4; ++m)
#pragma unroll
              for (int bj = 0; bj < 2; ++bj)
#pragma unroll
                for (int n = 0; n < 2; ++n) acc[ai][bj][m][n] = acc[ai][bj][m][n] * rsr[ai][m];
        }
#pragma unroll
        for (int ai = 0; ai < 2; ++ai) {
          f32x4 p1p[2], p2p[2];
          p1p[0] = p1p[1] = p2p[0] = p2p[1] = (f32x4){0.f, 0.f, 0.f, 0.f};
          const int q4 = ai * 2 + wr;
#pragma unroll
          for (int m = 0; m < 4; ++m) {
            const int r = ai * 128 + wr * 64 + m * 16 + fr;
            unsigned ow[4];
#pragma unroll
            for (int n = 0; n < 2; ++n) {
              const f32x4 g0 = acc[ai][0][m][n], v = acc[ai][1][m][n];
              f32x4 p1, p2;
              p1.x = dpp_ror1(g0.x); p1.y = dpp_ror1(g0.y); p1.z = dpp_ror1(g0.z); p1.w = dpp_ror1(g0.w);
              p2.x = dpp_ror2(g0.x); p2.y = dpp_ror2(g0.y); p2.z = dpp_ror2(g0.z); p2.w = dpp_ror2(g0.w);
              const f32x4 g1 = (fr >= 1) ? p1 : p1p[n], g2 = (fr >= 2) ? p2 : p2p[n];
              p1p[n] = p1; p2p[n] = p2;
              const f32x4 c = cb[n] + w0[n] * g2 + w1[n] * g1 + w2[n] * g0;
              ow[2 * n] = pk2(gelu_f(c.x) * v.x, gelu_f(c.y) * v.y); ow[2 * n + 1] = pk2(gelu_f(c.z) * v.z, gelu_f(c.w) * v.w);
            }
            if (m > 0 || fr >= 2) {
              u32x4 o; o.x = ow[0]; o.y = ow[1]; o.z = ow[2]; o.w = ow[3];
              *(u32x4*)(hdn + ((size_t)pm * 256 + r) * DFF + fcol) = o;
            } else {
              float* gh = ge + (((size_t)pm * 4 + q4) * 4 + 2 + fr) * DFF + fcol; float* vp = vh + (((size_t)pm * 4 + q4) * 2 + fr) * DFF + fcol;
              *(f32x4*)gh = acc[ai][0][m][0]; *(f32x4*)(gh + 4) = acc[ai][0][m][1]; *(f32x4*)vp = acc[ai][1][m][0]; *(f32x4*)(vp + 4) = acc[ai][1][m][1];
            }
            if (m == 3 && fr >= 14) {
              float* gt = ge + (((size_t)pm * 4 + q4) * 4 + (fr - 14)) * DFF + fcol;
              *(f32x4*)gt = acc[ai][0][m][0]; *(f32x4*)(gt + 4) = acc[ai][0][m][1];
            }
          }
        }
      } else if (kind == G_FFN2 || kind == G_GLU || kind == G_POOL) {
        bf16_t* mb = (bf16_t*)(ws2 + O_MB);
        float* rss = (float*)(ws2 + O_RSS) + (size_t)(pn * 4 + wc) * NTOK;
        const bf16_t* yb = (const bf16_t*)(ws2 + O_YB);
        f32x4 pa[2], pb[2];
#pragma unroll
        for (int bj = 0; bj < 2; ++bj) {
          const int col = 256 * pn + 128 * bj + lc0;
          if (kind == G_GLU) { const float* bg = kp2->bglu + (size_t)j2 * DM + col; pa[bj] = *(const f32x4*)bg; pb[bj] = *(const f32x4*)(bg + 4); }
          else if (kind == G_POOL) { const float* sc = kp2->pscale + (size_t)j2 * DM + col; pa[bj] = *(const f32x4*)sc; pb[bj] = *(const f32x4*)(sc + 4); }
          else { pa[bj] = pb[bj] = (f32x4){0.f, 0.f, 0.f, 0.f}; }
        }
#pragma unroll
        for (int ai = 0; ai < 2; ++ai) {
          u32x4 yv[4][2];
          if (kind == G_GLU) {
#pragma unroll
            for (int m = 0; m < 4; ++m)
#pragma unroll
              for (int bj = 0; bj < 2; ++bj)
                yv[m][bj] = *(const u32x4*)(yb + ((size_t)pm * 256 + ai * 128 + wr * 64 + m * 16 + fr) * DM + 256 * pn + 128 * bj + lc0);
          }
#pragma unroll
          for (int m = 0; m < 4; ++m) {
            const size_t row = (size_t)pm * 256 + ai * 128 + wr * 64 + m * 16 + fr;
            float ss = 0.f;
#pragma unroll
            for (int bj = 0; bj < 2; ++bj) {
              const int col = 256 * pn + 128 * bj + lc0;
              f32x4 va = acc[ai][bj][m][0], vb = acc[ai][bj][m][1];
              if (kind == G_GLU) {
                const f32x4 ba = pa[bj], bb = pb[bj];
                const u32x4 y = yv[m][bj];
                va.x = bf_lo(y.x) * sigmoid_f(va.x + ba.x); va.y = bf_hi(y.x) * sigmoid_f(va.y + ba.y);
                va.z = bf_lo(y.y) * sigmoid_f(va.z + ba.z); va.w = bf_hi(y.y) * sigmoid_f(va.w + ba.w);
                vb.x = bf_lo(y.z) * sigmoid_f(vb.x + bb.x); vb.y = bf_hi(y.z) * sigmoid_f(vb.y + bb.y);
                vb.z = bf_lo(y.w) * sigmoid_f(vb.z + bb.z); vb.w = bf_hi(y.w) * sigmoid_f(vb.w + bb.w);
              } else if (kind == G_POOL) {
                va = va * pa[bj]; vb = vb * pb[bj];
              }
              ss += va.x * va.x + va.y * va.y + va.z * va.z + va.w * va.w + vb.x * vb.x + vb.y * vb.y + vb.z * vb.z + vb.w * vb.w;
              u32x4 o; o.x = pk2(va.x, va.y); o.y = pk2(va.z, va.w); o.z = pk2(vb.x, vb.y); o.w = pk2(vb.z, vb.w);
              *(u32x4*)(mb + row * DM + col) = o;
            }
            ss += __shfl_xor(ss, 16); ss += __shfl_xor(ss, 32);
            if (fq == 0) rss[row] = ss;
          }
        }
      } else if (kind == G_S) {
        bf16_t* S = (bf16_t*)(ws2 + O_S) + ((size_t)grp * NCR + (size_t)pm * 256) * 256;
#pragma unroll
        for (int ai = 0; ai < 2; ++ai)
#pragma unroll
          for (int m = 0; m < 4; ++m) {
            const int r = ai * 128 + wr * 64 + m * 16 + fr;
#pragma unroll
            for (int bj = 0; bj < 2; ++bj) {
              const f32x4 va = acc[ai][bj][m][0], vb = acc[ai][bj][m][1];
              u32x4 o; o.x = pk2(va.x, va.y); o.y = pk2(va.z, va.w); o.z = pk2(vb.x, vb.y); o.w = pk2(vb.z, vb.w);
              *(u32x4*)(S + (size_t)r * 256 + 128 * bj + lc0) = o;
            }
          }
      } else {
        bf16_t* yb = (bf16_t*)(ws2 + O_YB);
#pragma unroll
        for (int ai = 0; ai < 2; ++ai)
#pragma unroll
          for (int m = 0; m < 4; ++m) {
            const size_t cr = (size_t)pm * 256 + ai * 128 + wr * 64 + m * 16 + fr;
#pragma unroll
            for (int bj = 0; bj < 2; ++bj) {
              const int lc = 128 * bj + lc0, t = lc >> 4, i0 = lc & 15;
              const f32x4 va = acc[ai][bj][m][0], vb = acc[ai][bj][m][1];
              u32x4 o; o.x = pk2(gelu_f(va.x), gelu_f(va.y)); o.y = pk2(gelu_f(va.z), gelu_f(va.w));
              o.z = pk2(gelu_f(vb.x), gelu_f(vb.y)); o.w = pk2(gelu_f(vb.z), gelu_f(vb.w));
              *(u32x4*)(yb + (cr * 16 + t) * DM + 16 * grp + i0) = o;
            }
          }
      }
    }
    if (!has_next) break;
    cur = nxt; L = Ln;
  }
  WAIT_V(0);
  if (wr_u == 0) BAR;
  BAR;
}

__device__ __forceinline__ void fixup_phase(const int wv, int layer) {
  PHASE_IDS();
  const float* ge = (const float*)(ws + O_GE); const float* vh = (const float*)(ws + O_VH);
  bf16_t* hdn = (bf16_t*)(ws + O_HDN);
  const int total = 256 * 4 * 2 * (DFF / 4);
  for (int e = bid * 512 + tid; e < total; e += nblk * 512) {
    const int c4 = e % (DFF / 4), pr = e / (DFF / 4), r = pr & 1, blk = pr >> 1, q4 = blk & 3, pm = blk >> 2, col = c4 * 4;
    const f32x4 z = {0.f, 0.f, 0.f, 0.f};
    const bool first = (q4 == 0) && ((pm & 7) == 0);
    const size_t pb = (size_t)blk - 1;
    const f32x4 t0 = first ? z : *(const f32x4*)(ge + (pb * 4 + 0) * DFF + col);
    const f32x4 t1 = first ? z : *(const f32x4*)(ge + (pb * 4 + 1) * DFF + col);
    const f32x4 h0 = *(const f32x4*)(ge + ((size_t)blk * 4 + 2) * DFF + col);
    const f32x4 h1 = *(const f32x4*)(ge + ((size_t)blk * 4 + 3) * DFF + col);
    const f32x4 v = *(const f32x4*)(vh + ((size_t)blk * 2 + r) * DFF + col);
    const f32x4 g0 = r ? h1 : h0, g1 = r ? h0 : t1, g2 = r ? t1 : t0;
    const float* cw = kp->convw + (size_t)layer * 3 * DFF + col;
    const f32x4 c = *(const f32x4*)(kp->convb + (size_t)layer * DFF + col) + *(const f32x4*)cw * g2 + *(const f32x4*)(cw + DFF) * g1 + *(const f32x4*)(cw + 2 * DFF) * g0;
    u32x2 o; o.x = pk2(gelu_f(c.x) * v.x, gelu_f(c.y) * v.y); o.y = pk2(gelu_f(c.z) * v.z, gelu_f(c.w) * v.w);
    *(u32x2*)(hdn + ((size_t)pm * 256 + q4 * 64 + r) * DFF + col) = o;
  }
}

__device__ __forceinline__ void rowpass_phase(const int wv, const int mode, const int layer, const int layout) {
  PHASE_IDS();
  const bool has_m = mode != 0;
  const float* xin = kp->x;
  const float* gpost = (mode == 1 ? kp->n_mix_post : kp->n_ffn_post) + layer * DM;
  const float* gpre = mode == 0 ? kp->n_mix_pre : (mode == 1 ? kp->n_ffn_pre + layer * DM : kp->n_mix_pre + (layer + 1) * DM);
  float* xout = kp->out;
  const int wid = tid >> 6, lane = tid & 63;
#define ROFF(q) (512 * ((q) >> 1) + 8 * lane + 4 * ((q) & 1))
  const bf16_t* mb = (const bf16_t*)(ws + O_MB); const float* rss = (const float*)(ws + O_RSS);
  bf16_t* hb = (bf16_t*)(ws + O_HB); bf16_t* xb = (bf16_t*)(ws + O_XB); float* rs2b = (float*)(ws + O_RS2);
  bf16_t* stg = (bf16_t*)smem;
  f32x4 gpo[4], gpr[4];
#pragma unroll
  for (int q = 0; q < 4; ++q) {
    gpo[q] = has_m ? *(const f32x4*)(gpost + ROFF(q)) : (f32x4){0.f, 0.f, 0.f, 0.f};
    gpr[q] = (layout == 1 || layout == 2) ? *(const f32x4*)(gpre + ROFF(q)) : (f32x4){0.f, 0.f, 0.f, 0.f};
  }
  for (int it = bid; it < NTOK / 32; it += nblk) {
    const size_t tok0 = (size_t)it * 32 + 4 * wid;
    f32x4 xv[4][4]; u32x2 mv[4][4]; float ssv[4];
#pragma unroll
    for (int rr = 0; rr < 4; ++rr) {
      if (!has_m) {
#pragma unroll
        for (int q = 0; q < 4; ++q) xv[rr][q] = __builtin_nontemporal_load((const f32x4*)(xin + (tok0 + rr) * DM + ROFF(q)));
      } else {
#pragma unroll
        for (int qq = 0; qq < 2; ++qq) {
          const u32x4 xr = *(const u32x4*)(xb + (tok0 + rr) * DM + ROFF(2 * qq));
          xv[rr][2 * qq] = (f32x4){bf_lo(xr.x), bf_hi(xr.x), bf_lo(xr.y), bf_hi(xr.y)};
          xv[rr][2 * qq + 1] = (f32x4){bf_lo(xr.z), bf_hi(xr.z), bf_lo(xr.w), bf_hi(xr.w)};
          const u32x4 mr = __builtin_nontemporal_load((const u32x4*)(mb + (tok0 + rr) * DM + ROFF(2 * qq)));
          mv[rr][2 * qq] = (u32x2){mr.x, mr.y}; mv[rr][2 * qq + 1] = (u32x2){mr.z, mr.w};
        }
        ssv[rr] = rss[(size_t)(lane & 15) * NTOK + tok0 + rr];
      }
    }
#pragma unroll
    for (int rr = 0; rr < 4; ++rr) {
      const size_t tok = tok0 + rr; const int tl = 4 * wid + rr;
      if (has_m) {
        float ss = ssv[rr];
        ss += __shfl_xor(ss, 1); ss += __shfl_xor(ss, 2); ss += __shfl_xor(ss, 4); ss += __shfl_xor(ss, 8);
        const float rs = rsqrtf(ss * (1.0f / DM) + RMS_EPS);
#pragma unroll
        for (int q = 0; q < 4; ++q) {
          xv[rr][q].x += bf_lo(mv[rr][q].x) * rs * gpo[q].x; xv[rr][q].y += bf_hi(mv[rr][q].x) * rs * gpo[q].y;
          xv[rr][q].z += bf_lo(mv[rr][q].y) * rs * gpo[q].z; xv[rr][q].w += bf_hi(mv[rr][q].y) * rs * gpo[q].w;
        }
      }
      if (layout == 0) {
#pragma unroll
        for (int q = 0; q < 4; ++q) __builtin_nontemporal_store(xv[rr][q], (f32x4*)(xout + tok * DM + ROFF(q)));
      } else {
#pragma unroll
        for (int qq = 0; qq < 2; ++qq) { u32x4 o; o.x = pk2(xv[rr][2 * qq].x, xv[rr][2 * qq].y); o.y = pk2(xv[rr][2 * qq].z, xv[rr][2 * qq].w);
          o.z = pk2(xv[rr][2 * qq + 1].x, xv[rr][2 * qq + 1].y); o.w = pk2(xv[rr][2 * qq + 1].z, xv[rr][2 * qq + 1].w); *(u32x4*)(xb + tok * DM + ROFF(2 * qq)) = o; }
        float s2 = 0.f;
#pragma unroll
        for (int q = 0; q < 4; ++q) s2 += xv[rr][q].x * xv[rr][q].x + xv[rr][q].y * xv[rr][q].y + xv[rr][q].z * xv[rr][q].z + xv[rr][q].w * xv[rr][q].w;
        const float rs2 = rsqrtf(wave_sum(s2) * (1.0f / DM) + RMS_EPS);
        if (layout == 3) { if (lane == 0) rs2b[tok] = rs2; continue; }
#pragma unroll
        for (int qq = 0; qq < 2; ++qq) {
          const int q0 = 2 * qq, q1 = 2 * qq + 1;
          u32x4 o; o.x = pk2(xv[rr][q0].x * rs2 * gpr[q0].x, xv[rr][q0].y * rs2 * gpr[q0].y); o.y = pk2(xv[rr][q0].z * rs2 * gpr[q0].z, xv[rr][q0].w * rs2 * gpr[q0].w);
          o.z = pk2(xv[rr][q1].x * rs2 * gpr[q1].x, xv[rr][q1].y * rs2 * gpr[q1].y); o.w = pk2(xv[rr][q1].z * rs2 * gpr[q1].z, xv[rr][q1].w * rs2 * gpr[q1].w);
          if (layout == 1) *(u32x4*)(hb + tok * DM + ROFF(q0)) = o;
          else *(u32x4*)(stg + tl * 1024 + ROFF(q0)) = o;
        }
      }
    }
    if (layout == 2) {
      __syncthreads();
#pragma unroll
      for (int ps = 0; ps < 8; ++ps) {
        const int e = (ps * 512 + tid) * 8, c2 = e >> 14, e1 = e & 16383, gp = e1 >> 9, within = e1 & 511, gl = within >> 8, t = (within & 255) >> 4, i0 = within & 15;
        const u32x4 v = *(const u32x4*)(stg + (c2 * 16 + t) * 1024 + gp * 32 + gl * 16 + i0);
        *(u32x4*)(hb + ((size_t)gp * NCR + (size_t)it * 2 + c2) * 512 + within) = v;
      }
      __syncthreads();
    }
  }
#undef ROFF
}

template <int WIN> __device__ __forceinline__ void pool_item(const bf16_t* __restrict__ base, const float* __restrict__ rsp, bf16_t* __restrict__ dst, const int t0, const f32x4 ga, const f32x4 gb) {
  u32x4 rows[8 + WIN - 1]; float rsv[8 + WIN - 1];
#pragma unroll
  for (int k = 0; k < 8 + WIN - 1; ++k) {
    const int tt = t0 - (WIN - 1) + k;
    rows[k] = (tt >= 0) ? *(const u32x4*)(base + (long)tt * DM) : (u32x4){0u, 0u, 0u, 0u};
    rsv[k] = (tt >= 0) ? rsp[tt] : 0.f;
  }
#define POOL_CVT(c, k) float c[8]; { const u32x4 _v = rows[k]; const float _r = rsv[k]; \
    c[0] = bf_lo(_v.x) * _r * ga.x; c[1] = bf_hi(_v.x) * _r * ga.y; c[2] = bf_lo(_v.y) * _r * ga.z; c[3] = bf_hi(_v.y) * _r * ga.w; \
    c[4] = bf_lo(_v.z) * _r * gb.x; c[5] = bf_hi(_v.z) * _r * gb.y; c[6] = bf_lo(_v.w) * _r * gb.z; c[7] = bf_hi(_v.w) * _r * gb.w; }
  float sum[8];
#pragma unroll
  for (int u = 0; u < 8; ++u) sum[u] = 0.f;
#pragma unroll
  for (int k = 0; k < WIN - 1; ++k) {
    POOL_CVT(c, k)
#pragma unroll
    for (int u = 0; u < 8; ++u) sum[u] += c[u];
  }
#pragma unroll
  for (int u = 0; u < 8; ++u) {
    const int t = t0 + u;
    POOL_CVT(c, WIN - 1 + u)
    const float ic = (t + 1 >= WIN) ? (1.0f / (float)WIN) : 1.0f / (float)(t + 1);
#pragma unroll
    for (int e = 0; e < 8; ++e) sum[e] += c[e];
    u32x4 o; o.x = pk2(sum[0] * ic - c[0], sum[1] * ic - c[1]); o.y = pk2(sum[2] * ic - c[2], sum[3] * ic - c[3]);
    o.z = pk2(sum[4] * ic - c[4], sum[5] * ic - c[5]); o.w = pk2(sum[6] * ic - c[6], sum[7] * ic - c[7]);
    *(u32x4*)(dst + (long)t * DM) = o;
    POOL_CVT(w, u)
#pragma unroll
    for (int e = 0; e < 8; ++e) sum[e] -= w[e];
  }
#undef POOL_CVT
}
__device__ __forceinline__ void poolprep_phase(const int wv, const int layer) {
  PHASE_IDS();
  const bf16_t* xb = (const bf16_t*)(ws + O_XB); bf16_t* yb = (bf16_t*)(ws + O_YB); const float* rs2b = (const float*)(ws + O_RS2);
  const int oct = tid & 127, sub = tid >> 7, grp = oct >> 5;
  const float* gp = kp->n_mix_pre + layer * DM + oct * 8;
  const f32x4 ga = *(const f32x4*)gp, gb = *(const f32x4*)(gp + 4);
  for (int it = bid; it < NB * 64; it += nblk) {
    const int b = it >> 6, seg = it & 63, t0 = seg * 32 + sub * 8;
    const bf16_t* base = xb + (size_t)b * SEQ * DM + oct * 8;
    const float* rsp = rs2b + (size_t)b * SEQ;
    bf16_t* dst = yb + (size_t)b * SEQ * DM + oct * 8;
    if (grp == 0) pool_item<2>(base, rsp, dst, t0, ga, gb);
    else if (grp == 1) pool_item<4>(base, rsp, dst, t0, ga, gb);
    else if (grp == 2) pool_item<8>(base, rsp, dst, t0, ga, gb);
    else pool_item<16>(base, rsp, dst, t0, ga, gb);
  }
}

__device__ __forceinline__ void scan_phase(const int wv, int j2) {
  PHASE_IDS();
  const bf16_t* S = (const bf16_t*)(ws + O_S); bf16_t* H = (bf16_t*)(ws + O_HST);
  const float* AT = (const float*)(ws + O_AT) + (size_t)j2 * 64 * 64 * 2;
  for (int idx = bid * 512 + tid; idx < 32 * NB * 128; idx += nblk * 512) {
    const int gp = idx >> 12, rem = idx & 4095, b = rem >> 7, q = rem & 127, gl = q >> 6, pp = q & 63;
    const int g = 2 * gp + gl;
    const float ar = AT[(g * 64 + pp) * 2], ai = AT[(g * 64 + pp) * 2 + 1];
    float hr = 0.f, hi = 0.f;
    const size_t base = ((size_t)gp * NCR + (size_t)b * 128) * 256 + gl * 128 + pp;
    for (int c0 = 0; c0 < 128; c0 += 16) {
      bf16_t srv[16], siv[16];
#pragma unroll
      for (int u = 0; u < 16; ++u) { const size_t off = base + (size_t)(c0 + u) * 256; srv[u] = S[off]; siv[u] = S[off + 64]; }
#pragma unroll
      for (int u = 0; u < 16; ++u) {
        const size_t off = base + (size_t)(c0 + u) * 256;
        H[off] = (bf16_t)(pk2(hr, hr) & 0xffffu); H[off + 64] = (bf16_t)(pk2(hi, hi) & 0xffffu);
        const float sr = __uint_as_float((unsigned)srv[u] << 16), si = __uint_as_float((unsigned)siv[u] << 16);
        const float nr = ar * hr - ai * hi + sr, ni = ar * hi + ai * hr + si;
        hr = nr; hi = ni;
      }
    }
  }
}

__device__ __forceinline__ void transpose_item(const float* W, int ldw, int k0, int c0, bf16_t* dst, int ldd, float* scr, int lane, const float* gk = nullptr) {
#pragma unroll 8
  for (int i = 0; i < 32; ++i) { const int kk = 2 * i + (lane >> 5); scr[kk * 33 + (lane & 31)] = W[(size_t)(k0 + kk) * ldw + c0 + (lane & 31)] * (gk ? gk[k0 + kk] : 1.0f); }
  asm volatile("s_waitcnt lgkmcnt(0)" ::: "memory");
  const int c = lane & 7;
#pragma unroll
  for (int jj = 0; jj < 4; ++jj) {
    const int n = (lane >> 3) + 8 * jj; const float* s = scr + (8 * c) * 33 + perm32(n);
    u32x4 o; o.x = pk2(s[0 * 33], s[1 * 33]); o.y = pk2(s[2 * 33], s[3 * 33]); o.z = pk2(s[4 * 33], s[5 * 33]); o.w = pk2(s[6 * 33], s[7 * 33]);
    *(u32x4*)(dst + (size_t)n * ldd + 8 * c) = o;
  }
  asm volatile("s_waitcnt lgkmcnt(0)" ::: "memory");
}

__device__ __forceinline__ void prep_phase(const int wv) {
  PHASE_IDS();
  const int wid = tid >> 6, lane = tid & 63;
  float* lf = (float*)smem;
  float* apr = lf;
  float* api = apr + 17 * 64;
  float* Bbr = api + 17 * 64;
  float* Bbi = Bbr + 1024;
  float* Cr = Bbi + 1024;
  float* Ci = Cr + 1024;
  float* Kk = Ci + 1024;
  float* fre = Kk + 4096;
  float* fim = fre + 64;
  for (int it = bid; it < 128; it += nblk) {
    const int j = it >> 6, g = it & 63, gp = g >> 1, gl = g & 1;
    if (tid < 64) {
      const int pp = tid;
      const float lr = kp->lam_re[(j * 64 + g) * 64 + pp], li = kp->lam_im[(j * 64 + g) * 64 + pp];
      const float dt = expf(kp->log_dt[j * 64 + g]);
      const float mag = expf(lr * dt);
      float sn, cs; sincosf(li * dt, &sn, &cs);
      const float ar = mag * cs, ai = mag * sn;
      const float den = lr * lr + li * li, nr = ar - 1.0f, ni = ai;
      fre[pp] = (nr * lr + ni * li) / den; fim[pp] = (ni * lr - nr * li) / den;
      float pr = 1.0f, pi = 0.0f;
      for (int k = 0; k <= 16; ++k) { apr[k * 64 + pp] = pr; api[k * 64 + pp] = pi; const float t = pr * ar - pi * ai; pi = pr * ai + pi * ar; pr = t; }
      float* AT = (float*)(ws + O_AT) + ((size_t)(j * 64 + g) * 64 + pp) * 2;
      AT[0] = apr[16 * 64 + pp]; AT[1] = api[16 * 64 + pp];
    }
    __syncthreads();
    for (int e = tid; e < 1024; e += 512) {
      const int pp = e >> 4;
      const float br = kp->b_re[(size_t)(j * 64 + g) * 1024 + e], bi = kp->b_im[(size_t)(j * 64 + g) * 1024 + e];
      Bbr[e] = fre[pp] * br - fim[pp] * bi; Bbi[e] = fre[pp] * bi + fim[pp] * br;
      Cr[e] = kp->c_re[(size_t)(j * 64 + g) * 1024 + e]; Ci[e] = kp->c_im[(size_t)(j * 64 + g) * 1024 + e];
    }
    __syncthreads();
    for (int e = tid; e < 4096; e += 512) {
      const int k = e >> 8, i = (e >> 4) & 15, jj = e & 15;
      float a = 0.f;
      for (int pp = 0; pp < 64; ++pp) {
        const float wr_ = apr[k * 64 + pp] * Bbr[pp * 16 + jj] - api[k * 64 + pp] * Bbi[pp * 16 + jj];
        const float wi_ = apr[k * 64 + pp] * Bbi[pp * 16 + jj] + api[k * 64 + pp] * Bbr[pp * 16 + jj];
        a += Cr[i * 64 + pp] * wr_ - Ci[i * 64 + pp] * wi_;
      }
      if (k == 0 && i == jj) a += kp->s5d[(size_t)j * DM + 16 * g + i];
      Kk[e] = a;
    }
    __syncthreads();
    bf16_t* ME = (bf16_t*)(ws + O_ME) + ((size_t)j * 64 + g) * 256 * 384;
    for (int v = tid; v < 256 * 48; v += 512) {
      const int R = v / 48, kc0 = (v % 48) * 8, lr_ = slot2col(R), t = lr_ >> 4, i = lr_ & 15;
      float val[8];
#pragma unroll
      for (int u = 0; u < 8; ++u) {
        const int kc = kc0 + u;
        if (kc < 256) { const int s = kc >> 4, jj = kc & 15; val[u] = (s <= t) ? Kk[((t - s) * 16 + i) * 16 + jj] : 0.f; }
        else {
          const int q = kc - 256, pp = q & 63;
          const float alr = apr[(t + 1) * 64 + pp], ali = api[(t + 1) * 64 + pp];
          val[u] = (q < 64) ? (Cr[i * 64 + pp] * alr - Ci[i * 64 + pp] * ali) : (-Cr[i * 64 + pp] * ali - Ci[i * 64 + pp] * alr);
        }
      }
      u32x4 o; o.x = pk2(val[0], val[1]); o.y = pk2(val[2], val[3]); o.z = pk2(val[4], val[5]); o.w = pk2(val[6], val[7]);
      *(u32x4*)(ME + (size_t)R * 384 + kc0) = o;
    }
    bf16_t* FB = (bf16_t*)(ws + O_FBD) + ((size_t)j * 32 + gp) * 256 * 512;
    for (int v = tid; v < 128 * 64; v += 512) {
      const int R = gl * 128 + (v >> 6), kc0 = (v & 63) * 8, lr_ = slot2col(R), q = lr_ & 127, pp = q & 63;
      u32x4 o = {0u, 0u, 0u, 0u};
      if ((kc0 >> 8) == gl) {
        const int s = (kc0 & 255) >> 4, j0 = kc0 & 15;
        const float alr = apr[(15 - s) * 64 + pp], ali = api[(15 - s) * 64 + pp];
        float val[8];
#pragma unroll
        for (int u = 0; u < 8; ++u) {
          const float br = Bbr[pp * 16 + j0 + u], bi = Bbi[pp * 16 + j0 + u];
          val[u] = (q < 64) ? (alr * br - ali * bi) : (alr * bi + ali * br);
        }
        o.x = pk2(val[0], val[1]); o.y = pk2(val[2], val[3]); o.z = pk2(val[4], val[5]); o.w = pk2(val[6], val[7]);
      }
      *(u32x4*)(FB + (size_t)R * 512 + kc0) = o;
    }
    __syncthreads();
  }
  __syncthreads();
  float* scr = (float*)smem + wid * (64 * 33);
  const int gw = bid * 8 + wid, ngw = nblk * 8;
  constexpr int I_W1 = 16 * 176, I_W2 = 44 * 32, I_WG = 16 * 32, I_WP = 4 * 8;
  constexpr int NITEMS = 4 * I_W1 + 4 * I_W2 + 2 * I_WG + 8 * I_WP;
  for (int it = gw; it < NITEMS; it += ngw) {
    int r = it;
    if (r < 4 * I_W1) {
      const int layer = r / I_W1, q = r % I_W1, kb = q / 176, nb = q % 176, n0 = nb * 32, jt = n0 >> 8, l0 = n0 & 255;
      const float* W = (l0 < 128 ? kp->wgate : kp->wval) + (size_t)layer * DM * DFF;
      transpose_item(W, DFF, kb * 64, 128 * jt + (l0 & 127), (bf16_t*)(ws + O_W1T) + ((size_t)layer * 5632 + n0) * 1024 + kb * 64, 1024, scr, lane, kp->n_ffn_pre + layer * DM);
      continue;
    }
    r -= 4 * I_W1;
    if (r < 4 * I_W2) {
      const int layer = r / I_W2, q = r % I_W2, kb = q / 32, nb = q % 32;
      transpose_item(kp->wdown + (size_t)layer * DFF * DM, DM, kb * 64, nb * 32, (bf16_t*)(ws + O_W2T) + ((size_t)layer * 1024 + nb * 32) * DFF + kb * 64, DFF, scr, lane);
      continue;
    }
    r -= 4 * I_W2;
    if (r < 2 * I_WG) {
      const int j = r / I_WG, q = r % I_WG, kb = q / 32, nb = q % 32;
      transpose_item(kp->wglu + (size_t)j * DM * DM, DM, kb * 64, nb * 32, (bf16_t*)(ws + O_WGT) + ((size_t)j * 1024 + nb * 32) * 1024 + kb * 64, 1024, scr, lane);
      continue;
    }
    r -= 2 * I_WG;
    { const int jg = r / I_WP, q = r % I_WP, kb = q / 8, nb = q % 8;
      transpose_item(kp->poolw + (size_t)jg * 256 * 256, 256, kb * 64, nb * 32, (bf16_t*)(ws + O_WPT) + ((size_t)jg * 256 + nb * 32) * 256 + kb * 64, 256, scr, lane); }
  }
  __syncthreads();
}

#define XB_TMO      128
#define XB_XCNT(j)  (256  + 64 * (j))
#define XB_XSUB(j)  (1280 + 64 * (j))
#define XB_XGEN(j)  (2304 + 64 * (j))
#define XB_TOP      3328
#define XB_TOPGEN   3392
#define XCD_BAR_WORDS 3456
#define XB_SPIN_CAP (1u << 18)
__device__ __forceinline__ unsigned xb_ld(unsigned* p) { return __hip_atomic_load(p, __ATOMIC_RELAXED, __HIP_MEMORY_SCOPE_AGENT); }
__device__ __forceinline__ unsigned xb_add(unsigned* p, unsigned v) { return __hip_atomic_fetch_add(p, v, __ATOMIC_RELAXED, __HIP_MEMORY_SCOPE_AGENT); }
__device__ __forceinline__ unsigned xb_xcc_id() { return (unsigned)__builtin_amdgcn_s_getreg((3 << 11) | 20) & 0xFu; }
#define XB_SPIN(cond, bar) do { unsigned _sp = 0; while (cond) { __builtin_amdgcn_s_sleep(1); \
    if ((++_sp & 255u) == 0u) { if (xb_ld(&(bar)[XB_TMO])) break; if (_sp > XB_SPIN_CAP) { atomicAdd(&(bar)[XB_TMO], 1u); break; } } } } while (0)
typedef volatile __attribute__((address_space(3))) unsigned* XST;
#define XB_ST() ((XST)((__attribute__((address_space(3))) unsigned char*)smem + 131072))
__device__ __forceinline__ void xcd_census(unsigned* bar, unsigned x, unsigned G, unsigned& nloc, unsigned& nx) {
  unsigned sum, cnt, mine, sp = 0u;
  for (;;) {
    sum = 0u; cnt = 0u; mine = 0u;
#pragma unroll
    for (unsigned j = 0; j < 16; ++j) { const unsigned c = xb_ld(&bar[XB_XCNT(j)]); sum += c; cnt += (c > 0u) ? 1u : 0u; mine = (j == x) ? c : mine; }
    if (sum == G) break;
    __builtin_amdgcn_s_sleep(1);
    if ((++sp & 255u) == 0u) { if (xb_ld(&bar[XB_TMO])) break; if (sp > XB_SPIN_CAP) { atomicAdd(&bar[XB_TMO], 1u); break; } }
  }
  nloc = mine > 0u ? mine : 1u; nx = cnt > 0u ? cnt : 1u;
}
__device__ __forceinline__ void gsync_init(const int wv) {
  PHASE_IDS();
  if (tid == 0) { XST st = XB_ST(); st[0] = 0u; st[1] = 0u; (void)xb_add(&((unsigned*)(ws + O_CTR))[XB_XCNT(xb_xcc_id())], 1u); }
  __syncthreads();
}
__device__ __forceinline__ void gsync(const int wv) {
  PHASE_IDS();
  unsigned* bar = (unsigned*)(ws + O_CTR);
  asm volatile("s_waitcnt vmcnt(0)" ::: "memory");
  __syncthreads();
  if (tid == 0) {
    const unsigned x = xb_xcc_id();
    XST st = XB_ST();
    __builtin_amdgcn_s_waitcnt(0);
    unsigned nloc = st[0], nx = st[1];
    if (nloc == 0u) { xcd_census(bar, x, (unsigned)nblk, nloc, nx); st[0] = nloc; st[1] = nx; }
    const unsigned old = xb_add(&bar[XB_XSUB(x)], 1u);
    const unsigned gen = old / nloc;
    if (old + 1u == (gen + 1u) * nloc) {
      __builtin_amdgcn_fence(__ATOMIC_RELEASE, "agent");
      asm volatile("s_waitcnt vmcnt(0)" ::: "memory");
      const unsigned og = xb_add(&bar[XB_TOP], 1u);
      const unsigned tg = og / nx;
      if (og + 1u == (tg + 1u) * nx) xb_add(&bar[XB_TOPGEN], 1u);
      else XB_SPIN(xb_ld(&bar[XB_TOPGEN]) == tg, bar);
      __builtin_amdgcn_fence(__ATOMIC_ACQUIRE, "agent");
      xb_add(&bar[XB_XGEN(x)], 1u);
      asm volatile("s_waitcnt vmcnt(0)" ::: "memory");
    } else {
      XB_SPIN(xb_ld(&bar[XB_XGEN(x)]) == gen, bar);
      __builtin_amdgcn_fence(__ATOMIC_ACQUIRE, "agent");
      asm volatile("s_waitcnt vmcnt(0)" ::: "memory");
    }
  }
  __syncthreads();
}

#ifndef PROBE_KIND
#define PROBE_KIND 0
#endif
#define T0(k) if ((PROBE_KIND >> (k)) & 1) tst = __builtin_amdgcn_s_memrealtime();
#define T1(k) if ((PROBE_KIND >> (k)) & 1) tacc += __builtin_amdgcn_s_memrealtime() - tst;
__global__ void __launch_bounds__(512, 2) mega(Params p) {
  cg::grid_group grid = cg::this_grid();
  const int wv = __builtin_amdgcn_readfirstlane((int)(threadIdx.x >> 6));
  unsigned long long tacc = 0, tst = 0; (void)tst;
  gsync_init(wv);
  T0(10) prep_phase(wv);
  rowpass_phase(wv, 0, 0, 2);
  gsync(wv); T1(10)
  { KP_GET(kq); if (kq->ws == nullptr) grid.sync(); }
  for (int i = 0; i < DEPTH; ++i) {
    if ((i & 1) == 0) {
      T0(4) gemm_phase(wv, G_S, i); gsync(wv); T1(4)
      T0(5) scan_phase(wv, i >> 1); gsync(wv); T1(5)
      T0(6) gemm_phase(wv, G_Y, i); gsync(wv); T1(6)
      T0(7) gemm_phase(wv, G_GLU, i); gsync(wv); T1(7)
    } else {
      T0(8) poolprep_phase(wv, i); gsync(wv); T1(8)
      T0(9) gemm_phase(wv, G_POOL, i); gsync(wv); T1(9)
    }
    T0(3) rowpass_phase(wv, 1, i, 3); gsync(wv); T1(3)
    T0(1) gemm_phase(wv, G_FFN1, i); gsync(wv); T1(1)
    T0(11) fixup_phase(wv, i); gsync(wv); T1(11)
    T0(2) gemm_phase(wv, G_FFN2, i); gsync(wv); T1(2)
    T0(3)
    if (i < DEPTH - 1) { rowpass_phase(wv, 2, i, ((i + 1) & 1) ? 3 : 2); gsync(wv); }
    else rowpass_phase(wv, 2, i, 0);
    T1(3)
  }
  if ((PROBE_KIND >> 12) & 1) { gsync(wv); tst = __builtin_amdgcn_s_memrealtime(); for (int k = 0; k < 100; ++k) gsync(wv); tacc = __builtin_amdgcn_s_memrealtime() - tst; }
  if (PROBE_KIND != 0) { PHASE_IDS(); if (bid == 0 && tid == 0) kp->out[0] += (float)tacc * 1e-4f; }
}

extern "C" void kernel_launch(void* const* d_in, const int* in_sizes, int n_in, void* d_out, int out_size, void* d_ws, size_t ws_size, hipStream_t stream) {
  static int grid_blocks = 0;
  if (!grid_blocks) {
    if (n_in != 22 || out_size != NTOK * DM || ws_size < WS_END) {
      fprintf(stderr, "kernel_launch: unexpected shapes (n_in %d out %d ws %zu need %zu)\n", n_in, out_size, ws_size, (size_t)WS_END);
      grid_blocks = -1; return;
    }
    int dev = 0, cus = 0, per_cu = 0;
    (void)hipGetDevice(&dev);
    (void)hipDeviceGetAttribute(&cus, hipDeviceAttributeMultiprocessorCount, dev);
    (void)hipFuncSetAttribute((const void*)mega, hipFuncAttributeMaxDynamicSharedMemorySize, LDS_BYTES);
    (void)hipOccupancyMaxActiveBlocksPerMultiprocessor(&per_cu, (const void*)mega, 512, LDS_BYTES);
    if (per_cu < 1) fprintf(stderr, "kernel_launch: occupancy query says %d blocks/CU\n", per_cu);
    grid_blocks = cus;
  }
  if (grid_blocks < 0) return;
  Params p{};
  const float** f = (const float**)&p;
  for (int i = 0; i < 22; ++i) f[i] = (const float*)d_in[i];
  p.out = (float*)d_out; p.ws = (unsigned char*)d_ws;
  (void)hipMemsetAsync((unsigned char*)d_ws + O_CTR, 0, 16384, stream);
  void* args[] = {&p};
  hipError_t e = hipLaunchCooperativeKernel((void*)mega, dim3(grid_blocks), dim3(512), args, LDS_BYTES, stream);
  if (e != hipSuccess) fprintf(stderr, "cooperative launch failed: %s (grid %d)\n", hipGetErrorString(e), grid_blocks);
}
```

```cpp
#include <hip/hip_runtime.h>
#include <hip/hip_cooperative_groups.h>
#include <cstdio>
namespace cg = cooperative_groups;

typedef unsigned short bf16_t;
typedef short bf16x8 __attribute__((ext_vector_type(8)));
typedef float f32x4 __attribute__((ext_vector_type(4)));
typedef unsigned u32x4 __attribute__((ext_vector_type(4)));
typedef unsigned u32x2 __attribute__((ext_vector_type(2)));

constexpr int DM = 1024, NB = 32, SEQ = 2048, NTOK = NB * SEQ, DFF = 2816, DEPTH = 4;
constexpr int NCR = NTOK / 16;
constexpr float RMS_EPS = 1e-6f;

constexpr size_t SZ_W1T = (size_t)4 * 5632 * 1024 * 2, SZ_W2T = (size_t)4 * 1024 * 2816 * 2, SZ_WGT = (size_t)2 * 1024 * 1024 * 2,
                 SZ_WPT = (size_t)2 * 4 * 256 * 256 * 2, SZ_FBD = (size_t)2 * 32 * 256 * 512 * 2, SZ_ME = (size_t)2 * 64 * 256 * 384 * 2,
                 SZ_AT = (size_t)2 * 64 * 64 * 2 * 4, SZ_RSS = (size_t)16 * NTOK * 4, SZ_HALO = (size_t)256 * 2 * DFF * 4,
                 SZ_ACT = (size_t)NTOK * DM * 2, SZ_HDN = (size_t)NTOK * DFF * 2;
constexpr size_t O_W1T = 0, O_W2T = O_W1T + SZ_W1T, O_WGT = O_W2T + SZ_W2T, O_WPT = O_WGT + SZ_WGT, O_FBD = O_WPT + SZ_WPT,
                 O_ME = O_FBD + SZ_FBD, O_AT = O_ME + SZ_ME, O_RSS = O_AT + SZ_AT, O_GTAIL = O_RSS + SZ_RSS, O_GHEAD = O_GTAIL + SZ_HALO,
                 O_VHEAD = O_GHEAD + SZ_HALO, O_HB = O_VHEAD + SZ_HALO, O_YB = O_HB + SZ_ACT, O_MB = O_YB + SZ_ACT, O_HDN = O_MB + SZ_ACT,
                 O_CTR = O_HDN + SZ_HDN, O_XB = O_CTR + 16384, O_RS2 = O_XB + SZ_ACT, WS_END = O_RS2 + (size_t)NTOK * 4;
constexpr size_t O_GE = O_YB;
constexpr size_t O_VH = O_YB + (size_t)256 * 4 * 4 * DFF * 4;
static_assert(O_VH + (size_t)256 * 4 * 2 * DFF * 4 <= O_YB + SZ_ACT, "alias");
constexpr size_t O_S = O_HDN;
constexpr size_t O_HST = O_HDN + (size_t)32 * 4096 * 256 * 4;
static_assert(O_HST + (size_t)32 * 4096 * 256 * 2 <= WS_END, "alias");
constexpr int LDS_BYTES = 131072 + 16;

struct Params {
  const float *x, *lam_re, *lam_im, *log_dt, *b_re, *b_im, *c_re, *c_im, *s5d, *wglu, *bglu, *poolw, *pscale, *wgate, *wval, *convw, *convb,
      *wdown, *n_mix_pre, *n_mix_post, *n_ffn_pre, *n_ffn_post;
  float* out;
  unsigned char* ws;
};

extern __shared__ __attribute__((aligned(16))) char smem[];

typedef const __attribute__((address_space(4))) Params* KP;
#define KP_GET(name) KP name = (KP)__builtin_amdgcn_kernarg_segment_ptr(); asm volatile("" : "+s"(name))
#define PHASE_IDS() int tid; asm volatile("v_mbcnt_lo_u32_b32 %0, -1, 0\n\tv_mbcnt_hi_u32_b32 %0, -1, %0" : "=v"(tid)); tid |= (wv << 6); int bid = blockIdx.x; asm volatile("" : "+s"(bid)); KP_GET(kp); unsigned char* ws = kp->ws; const int nblk = gridDim.x; (void)bid; (void)ws; (void)nblk
__device__ __forceinline__ unsigned pk2(float lo, float hi) { unsigned r; asm("v_cvt_pk_bf16_f32 %0, %1, %2" : "=v"(r) : "v"(lo), "v"(hi)); return r; }
__device__ __forceinline__ float bf_lo(unsigned u) { return __uint_as_float(u << 16); }
__device__ __forceinline__ float bf_hi(unsigned u) { return __uint_as_float(u & 0xffff0000u); }
__device__ __forceinline__ float sigmoid_f(float z) { return __builtin_amdgcn_rcpf(1.0f + __builtin_amdgcn_exp2f(-1.4426950408889634f * z)); }
__device__ __forceinline__ float sig_fold(float z, float bneg) { return __builtin_amdgcn_rcpf(1.0f + __builtin_amdgcn_exp2f(__builtin_fmaf(z, -1.4426950408889634f, bneg))); }
__device__ __forceinline__ float gelu_f(float v) {
  const float p = __builtin_fmaf(v * v, -2.3022081981f * 0.044715f, -2.3022081981f);
  return v * __builtin_amdgcn_rcpf(1.0f + __builtin_amdgcn_exp2f(v * p));
}
__device__ __forceinline__ float wave_sum(float v) {
#pragma unroll
  for (int o = 1; o < 64; o <<= 1) v += __shfl_xor(v, o);
  return v;
}
__device__ __forceinline__ int perm32(int rho) { const int n = rho >> 4, i = rho & 15; return 8 * (i >> 2) + 4 * n + (i & 3); }
__device__ __forceinline__ int slot2col(int R) { return (R & ~31) + perm32(R & 31); }

constexpr int HT = 128 * 64;
__device__ __forceinline__ int lds_byte(int r, int c) {
  int st = (r >> 4) * 2 + (c >> 5), rr = r & 15, cc = c & 31, ob = rr * 64 + cc * 2;
  return st * 1024 + (ob ^ (((ob >> 9) & 1) << 5));
}
struct Unit { const char* A; const char* A2; const char* B; int pm, pn, grp; };
__device__ __forceinline__ float dpp_ror1(float v) { return __int_as_float(__builtin_amdgcn_mov_dpp(__float_as_int(v), 0x121, 0xf, 0xf, false)); }
__device__ __forceinline__ float dpp_ror2(float v) { return __int_as_float(__builtin_amdgcn_mov_dpp(__float_as_int(v), 0x122, 0xf, 0xf, false)); }

template <int WG = 8> __device__ __forceinline__ void tile_map(int L, int nM, int nN, int& pm, int& pn) {
  const int nwg = nM * nN; int wgid = L;
  { const int q = nwg / 8, r = nwg % 8, xcd = wgid % 8, off = wgid / 8; wgid = (xcd < r ? xcd * (q + 1) : r * (q + 1) + (xcd - r) * q) + off; }
  const int nig = WG * nN, gid = wgid / nig, fm = gid * WG, gsz = (nM - fm) < WG ? (nM - fm) : WG;
  pm = fm + ((wgid % nig) % gsz); pn = (wgid % nig) / gsz;
}

enum { G_FFN1 = 0, G_FFN2 = 1, G_GLU = 2, G_POOL = 3, G_S = 4, G_Y = 5 };

__device__ __forceinline__ void gemm_phase(const int wv, const int kind, const int layer) {
  PHASE_IDS();
  const int j2 = layer >> 1;
  int ntiles, nt, ksplit, lda, lda2 = 0, ldb;
  switch (kind) {
    case G_FFN1: ntiles = 256 * 22; nt = 16; lda = 1024; ldb = 1024; break;
    case G_FFN2: ntiles = 1024; nt = 44; lda = DFF; ldb = DFF; break;
    case G_GLU: ntiles = 1024; nt = 16; lda = 1024; ldb = 1024; break;
    case G_POOL: ntiles = 1024; nt = 4; lda = 1024; ldb = 256; break;
    case G_S: ntiles = 512; nt = 8; lda = 512; ldb = 512; break;
    default: ntiles = 1024; nt = 6; lda = 512; lda2 = 256; ldb = 384; break;
  }
  ksplit = (kind == G_Y) ? 4 : nt;
  typedef __attribute__((address_space(3))) unsigned char* LP;
  const LP lds = (LP)smem;
  unsigned voA, voA2, voB, voAh, voA2h, voBh; int aoff, boff;
  {
    const int wid = wv, lane = tid & 63, wr = wid >> 2, wc = wid & 3, fr = lane & 15, fq = lane >> 4;
    const int sb = lane * 16, swz = sb ^ (((sb >> 9) & 1) << 5), s_r = (wid >> 1) * 16 + swz / 64, s_c = (wid & 1) * 32 + (swz % 64) / 2;
    voA = (unsigned)(s_r * lda + s_c) * 2u; voA2 = (unsigned)(s_r * lda2 + s_c) * 2u; voB = (unsigned)(s_r * ldb + s_c) * 2u;
    voAh = voA + 128u * lda; voA2h = voA2 + 128u * lda2; voBh = voB + 128u * ldb;
    aoff = lds_byte(wr * 64 + fr, fq * 8); boff = lds_byte(wc * 32 + fr, fq * 8);
  }
  const int wr_u = wv >> 2;
  const unsigned ldsw = (unsigned)wv * 1024u;
  const unsigned ldsbase = (unsigned)(unsigned long)lds + ldsw;
  auto get_unit = [&](const int L, Unit& u) {
    int pm = 0, pn = 0, grp = 0; u.A2 = nullptr;
    if (kind == G_FFN1) {
      tile_map<4>(L, 256, 22, pm, pn);
      u.A = (const char*)((const bf16_t*)(ws + O_XB) + (size_t)pm * 256 * 1024);
      u.B = (const char*)((const bf16_t*)(ws + O_W1T) + ((size_t)layer * 5632 + (size_t)pn * 256) * 1024);
    } else if (kind == G_FFN2) {
      tile_map<4>(L, 256, 4, pm, pn);
      u.A = (const char*)((const bf16_t*)(ws + O_HDN) + (size_t)pm * 256 * DFF);
      u.B = (const char*)((const bf16_t*)(ws + O_W2T) + ((size_t)layer * 1024 + (size_t)pn * 256) * DFF);
    } else if (kind == G_GLU) {
      tile_map(L, 256, 4, pm, pn);
      u.A = (const char*)((const bf16_t*)(ws + O_YB) + (size_t)pm * 256 * 1024);
      u.B = (const char*)((const bf16_t*)(ws + O_WGT) + ((size_t)j2 * 1024 + (size_t)pn * 256) * 1024);
    } else if (kind == G_POOL) {
      tile_map(L, 256, 4, pm, pn);
      u.A = (const char*)((const bf16_t*)(ws + O_YB) + (size_t)pm * 256 * 1024 + 256 * pn);
      u.B = (const char*)((const bf16_t*)(ws + O_WPT) + ((size_t)j2 * 4 + pn) * 256 * 256);
    } else if (kind == G_S) {
      grp = L >> 4; pm = L & 15;
      u.A = (const char*)((const bf16_t*)(ws + O_HB) + ((size_t)grp * NCR + (size_t)pm * 256) * 512);
      u.B = (const char*)((const bf16_t*)(ws + O_FBD) + ((size_t)j2 * 32 + grp) * 256 * 512);
    } else {
      grp = L >> 4; pm = L & 15;
      const int gp = grp >> 1, gl = grp & 1;
      u.A = (const char*)((const bf16_t*)(ws + O_HB) + ((size_t)gp * NCR + (size_t)pm * 256) * 512 + gl * 256);
      u.A2 = (const char*)((const bf16_t*)(ws + O_HST) + ((size_t)gp * NCR + (size_t)pm * 256) * 256 + gl * 128);
      u.B = (const char*)((const bf16_t*)(ws + O_ME) + ((size_t)j2 * 64 + grp) * 256 * 384);
    }
    u.pm = pm; u.pn = pn; u.grp = grp;
  };
#define BUF_A(b, h) (((b) * 2 + (h)) * 16384)
#define BUF_B(b, h) ((4 + (b) * 2 + (h)) * 16384)
#define GLDS(voff_, sbase_, ldsaddr_) asm volatile("s_mov_b32 m0, %2\n\ts_nop 0\n\tglobal_load_lds_dwordx4 %0, %1" :: "v"(voff_), "s"(sbase_), "s"(ldsaddr_) : "memory", "m0")
#define STAGE_A(bufoff, u, half, kt) do { const char* _sb; unsigned _o, _o2; \
    if (kind != G_Y || (kt) < ksplit) { _sb = (u).A + (size_t)(kt) * 128 + (size_t)(half) * 256 * lda; _o = voA; _o2 = voAh; } \
    else { _sb = (u).A2 + (size_t)((kt) - ksplit) * 128 + (size_t)(half) * 256 * lda2; _o = voA2; _o2 = voA2h; } \
    GLDS(_o, _sb, ldsbase + (unsigned)(bufoff)); GLDS(_o2, _sb, ldsbase + (unsigned)(bufoff) + 8192u); } while (0)
#define STAGE_B(bufoff, u, half, kt) do { const char* _sb = (u).B + (size_t)(kt) * 128 + (size_t)(half) * 256 * ldb; \
    GLDS(voB, _sb, ldsbase + (unsigned)(bufoff)); GLDS(voBh, _sb, ldsbase + (unsigned)(bufoff) + 8192u); } while (0)
#define LDA(dst, b, h) do { _Pragma("unroll") for (int m = 0; m < 4; ++m) _Pragma("unroll") for (int k = 0; k < 2; ++k) \
    dst[m][k] = *(const __attribute__((address_space(3))) bf16x8*)(lds + BUF_A(b, h) + aoff + m * 2048 + k * 1024); } while (0)
#define LDB(dst, b, h) do { _Pragma("unroll") for (int n = 0; n < 2; ++n) _Pragma("unroll") for (int k = 0; k < 2; ++k) \
    dst[n][k] = *(const __attribute__((address_space(3))) bf16x8*)(lds + BUF_B(b, h) + boff + n * 2048 + k * 1024); } while (0)
#define MMA(ai, bj, At_, Bt_) do { __builtin_amdgcn_s_setprio(1); \
    _Pragma("unroll") for (int m = 0; m < 4; ++m) _Pragma("unroll") for (int n = 0; n < 2; ++n) _Pragma("unroll") for (int k = 0; k < 2; ++k) \
      acc[ai][bj][m][n] = __builtin_amdgcn_mfma_f32_16x16x32_bf16(Bt_[n][k], At_[m][k], acc[ai][bj][m][n], 0, 0, 0); \
    __builtin_amdgcn_s_setprio(0); } while (0)
#define MMAZ(ai, bj, At_, Bt_) do { __builtin_amdgcn_s_setprio(1); \
    _Pragma("unroll") for (int m = 0; m < 4; ++m) _Pragma("unroll") for (int n = 0; n < 2; ++n) { \
      acc[ai][bj][m][n] = __builtin_amdgcn_mfma_f32_16x16x32_bf16(Bt_[n][0], At_[m][0], (f32x4){0.f, 0.f, 0.f, 0.f}, 0, 0, 0); \
      acc[ai][bj][m][n] = __builtin_amdgcn_mfma_f32_16x16x32_bf16(Bt_[n][1], At_[m][1], acc[ai][bj][m][n], 0, 0, 0); } \
    __builtin_amdgcn_s_setprio(0); } while (0)
#define WAIT_V(n) asm volatile("s_waitcnt vmcnt(" #n ")" ::: "memory")
#define WAIT_L(n) asm volatile("s_waitcnt lgkmcnt(" #n ")" ::: "memory")
#define BAR __builtin_amdgcn_s_barrier()
#define SCHED __builtin_amdgcn_sched_barrier(0)
#define ZERO_ACC() do { _Pragma("unroll") for (int a = 0; a < 2; ++a) _Pragma("unroll") for (int b = 0; b < 2; ++b) _Pragma("unroll") for (int m = 0; m < 4; ++m) \
    _Pragma("unroll") for (int n = 0; n < 2; ++n) acc[a][b][m][n] = (f32x4){0.f, 0.f, 0.f, 0.f}; } while (0)
  int L = bid;
  if (L >= ntiles) return;
  Unit cur, nxt;
  get_unit(L, cur);
  __builtin_amdgcn_s_waitcnt(0);
  f32x4 acc[2][2][4][2];
  bf16x8 At[4][2], B0[2][2], B1[2][2];
  STAGE_B(BUF_B(0, 0), cur, 0, 0); STAGE_A(BUF_A(0, 0), cur, 0, 0); STAGE_B(BUF_B(0, 1), cur, 1, 0); STAGE_A(BUF_A(0, 1), cur, 1, 0);
  if (wr_u == 1) BAR;
  WAIT_V(4); BAR;
  STAGE_B(BUF_B(1, 0), cur, 0, 1); STAGE_A(BUF_A(1, 0), cur, 0, 1); STAGE_B(BUF_B(1, 1), cur, 1, 1);
  WAIT_V(6); BAR;
  for (;;) {
    const int Ln = L + nblk; const bool has_next = Ln < ntiles;
    if (has_next) get_unit(Ln, nxt); else nxt = cur;
#define KBODY(MM) \
      LDB(B0, 0, 0); SCHED; LDA(At, 0, 0); STAGE_A(BUF_A(1, 1), cur, 1, t + 1); \
      WAIT_L(8); BAR; WAIT_L(0); MM(0, 0, At, B0); BAR; SCHED; \
      LDB(B1, 0, 1); STAGE_B(BUF_B(0, 0), u2, 0, k2); \
      BAR; WAIT_L(0); MM(0, 1, At, B1); BAR; \
      LDA(At, 0, 1); STAGE_A(BUF_A(0, 0), u2, 0, k2); \
      BAR; WAIT_L(0); MM(1, 0, At, B0); BAR; SCHED; \
      STAGE_B(BUF_B(0, 1), u2, 1, k2); \
      WAIT_V(6); BAR; MM(1, 1, At, B1); BAR; \
      LDB(B0, 1, 0); SCHED; LDA(At, 1, 0); STAGE_A(BUF_A(0, 1), u2, 1, k2); \
      WAIT_L(8); BAR; WAIT_L(0); MMA(0, 0, At, B0); BAR; SCHED; \
      LDB(B1, 1, 1); STAGE_B(BUF_B(1, 0), u2, 0, k3); \
      BAR; WAIT_L(0); MMA(0, 1, At, B1); BAR; \
      LDA(At, 1, 1); STAGE_A(BUF_A(1, 0), u2, 0, k3); \
      BAR; WAIT_L(0); MMA(1, 0, At, B0); BAR; SCHED; \
      STAGE_B(BUF_B(1, 1), u2, 1, k3); \
      WAIT_V(6); BAR; MMA(1, 1, At, B1); BAR;
    {
      const int t = 0, k2 = 2, k3 = 3; const Unit u2 = cur;
      KBODY(MMAZ)
    }
    int t_s = 2; asm volatile("" : "+s"(t_s));
    for (int t = t_s; t < nt; t += 2) {
      const bool last = (t == nt - 2);
      Unit u2 = cur; if (last) u2 = nxt;
      const int k2 = last ? 0 : t + 2, k3 = k2 + 1;
      KBODY(MMA)
    }
#undef KBODY
    {
      int tid2; asm volatile("v_mbcnt_lo_u32_b32 %0, -1, 0\n\tv_mbcnt_hi_u32_b32 %0, -1, %0" : "=v"(tid2)); tid2 |= (wv << 6);
      int pm = cur.pm, pn = cur.pn, grp = cur.grp;
      asm volatile("" : "+s"(pm), "+s"(pn), "+s"(grp)); KP_GET(kp2); unsigned char* ws2 = kp2->ws;
      const int wid = tid2 >> 6, lane = tid2 & 63, wr = wid >> 2, wc = wid & 3, fr = lane & 15, fq = lane >> 4;
      const int lc0 = wc * 32 + 8 * fq;
      if (kind == G_FFN1) {
        const int fcol = 128 * pn + lc0;
        const float* cw = kp2->convw + (size_t)layer * 3 * DFF + fcol;
        f32x4 w0[2], w1[2], w2[2], cb[2];
        w0[0] = *(const f32x4*)(cw); w0[1] = *(const f32x4*)(cw + 4); w1[0] = *(const f32x4*)(cw + DFF); w1[1] = *(const f32x4*)(cw + DFF + 4);
        w2[0] = *(const f32x4*)(cw + 2 * DFF); w2[1] = *(const f32x4*)(cw + 2 * DFF + 4);
        const float* cbp = kp2->convb + (size_t)layer * DFF + fcol;
        cb[0] = *(const f32x4*)(cbp); cb[1] = *(const f32x4*)(cbp + 4);
        bf16_t* hdn = (bf16_t*)(ws2 + O_HDN);
        float* ge = (float*)(ws2 + O_GE); float* vh = (float*)(ws2 + O_VH);
        {
          const float* rs2b = (const float*)(ws2 + O_RS2) + (size_t)pm * 256 + wr * 64 + fr;
          float rsr[2][4];
#pragma unroll
          for (int ai = 0; ai < 2; ++ai)
#pragma unroll
            for (int m = 0; m < 4; ++m) rsr[ai][m] = rs2b[ai * 128 + m * 16];
#pragma unroll
          for (int ai = 0; ai < 2; ++ai)
#pragma unroll
            for (int m = 0; m < 4; ++m)
#pragma unroll
              for (int bj = 0; bj < 2; ++bj)
#pragma unroll
                for (int n = 0; n < 2; ++n) acc[ai][bj][m][n] = acc[ai][bj][m][n] * rsr[ai][m];
        }
#pragma unroll
        for (int ai = 0; ai < 2; ++ai) {
          f32x4 p1p[2], p2p[2];
          p1p[0] = p1p[1] = p2p[0] = p2p[1] = (f32x4){0.f, 0.f, 0.f, 0.f};
          const int q4 = ai * 2 + wr;
#pragma unroll
          for (int m = 0; m < 4; ++m) {
            const int r = ai * 128 + wr * 64 + m * 16 + fr;
            unsigned ow[4];
#pragma unroll
            for (int n = 0; n < 2; ++n) {
              const f32x4 g0 = acc[ai][0][m][n], v = acc[ai][1][m][n];
              f32x4 p1, p2;
              p1.x = dpp_ror1(g0.x); p1.y = dpp_ror1(g0.y); p1.z = dpp_ror1(g0.z); p1.w = dpp_ror1(g0.w);
              p2.x = dpp_ror2(g0.x); p2.y = dpp_ror2(g0.y); p2.z = dpp_ror2(g0.z); p2.w = dpp_ror2(g0.w);
              const f32x4 g1 = (fr >= 1) ? p1 : p1p[n], g2 = (fr >= 2) ? p2 : p2p[n];
              p1p[n] = p1; p2p[n] = p2;
              const f32x4 c = cb[n] + w0[n] * g2 + w1[n] * g1 + w2[n] * g0;
              ow[2 * n] = pk2(gelu_f(c.x) * v.x, gelu_f(c.y) * v.y); ow[2 * n + 1] = pk2(gelu_f(c.z) * v.z, gelu_f(c.w) * v.w);
            }
            if (m > 0 || fr >= 2) {
              u32x4 o; o.x = ow[0]; o.y = ow[1]; o.z = ow[2]; o.w = ow[3];
              *(u32x4*)(hdn + ((size_t)pm * 256 + r) * DFF + fcol) = o;
            } else {
              float* gh = ge + (((size_t)pm * 4 + q4) * 4 + 2 + fr) * DFF + fcol; float* vp = vh + (((size_t)pm * 4 + q4) * 2 + fr) * DFF + fcol;
              *(f32x4*)gh = acc[ai][0][m][0]; *(f32x4*)(gh + 4) = acc[ai][0][m][1]; *(f32x4*)vp = acc[ai][1][m][0]; *(f32x4*)(vp + 4) = acc[ai][1][m][1];
            }
            if (m == 3 && fr >= 14) {
              float* gt = ge + (((size_t)pm * 4 + q4) * 4 + (fr - 14)) * DFF + fcol;
              *(f32x4*)gt = acc[ai][0][m][0]; *(f32x4*)(gt + 4) = acc[ai][0][m][1];
            }
          }
        }
      } else if (kind == G_FFN2 || kind == G_GLU || kind == G_POOL) {
        bf16_t* mb = (bf16_t*)(ws2 + O_MB);
        float* rss = (float*)(ws2 + O_RSS) + (size_t)(pn * 4 + wc) * NTOK;
        const bf16_t* yb = (const bf16_t*)(ws2 + O_YB);
        f32x4 pa[2], pb[2];
#pragma unroll
        for (int bj = 0; bj < 2; ++bj) {
          const int col = 256 * pn + 128 * bj + lc0;
          if (kind == G_GLU) { const float* bg = kp2->bglu + (size_t)j2 * DM + col; pa[bj] = *(const f32x4*)bg * -1.4426950408889634f; pb[bj] = *(const f32x4*)(bg + 4) * -1.4426950408889634f; }
          else if (kind == G_POOL) { const float* sc = kp2->pscale + (size_t)j2 * DM + col; pa[bj] = *(const f32x4*)sc; pb[bj] = *(const f32x4*)(sc + 4); }
          else { pa[bj] = pb[bj] = (f32x4){0.f, 0.f, 0.f, 0.f}; }
        }
#pragma unroll
        for (int ai = 0; ai < 2; ++ai) {
          u32x4 yv[4][2];
          if (kind == G_GLU) {
#pragma unroll
            for (int m = 0; m < 4; ++m)
#pragma unroll
              for (int bj = 0; bj < 2; ++bj)
                yv[m][bj] = *(const u32x4*)(yb + ((size_t)pm * 256 + ai * 128 + wr * 64 + m * 16 + fr) * DM + 256 * pn + 128 * bj + lc0);
          }
#pragma unroll
          for (int m = 0; m < 4; ++m) {
            const size_t row = (size_t)pm * 256 + ai * 128 + wr * 64 + m * 16 + fr;
            float ss = 0.f;
#pragma unroll
            for (int bj = 0; bj < 2; ++bj) {
              const int col = 256 * pn + 128 * bj + lc0;
              f32x4 va = acc[ai][bj][m][0], vb = acc[ai][bj][m][1];
              if (kind == G_GLU) {
                const f32x4 ba = pa[bj], bb = pb[bj];
                const u32x4 y = yv[m][bj];
                va.x = bf_lo(y.x) * sig_fold(va.x, ba.x); va.y = bf_hi(y.x) * sig_fold(va.y, ba.y);
                va.z = bf_lo(y.y) * sig_fold(va.z, ba.z); va.w = bf_hi(y.y) * sig_fold(va.w, ba.w);
                vb.x = bf_lo(y.z) * sig_fold(vb.x, bb.x); vb.y = bf_hi(y.z) * sig_fold(vb.y, bb.y);
                vb.z = bf_lo(y.w) * sig_fold(vb.z, bb.z); vb.w = bf_hi(y.w) * sig_fold(vb.w, bb.w);
              } else if (kind == G_POOL) {
                va = va * pa[bj]; vb = vb * pb[bj];
              }
              ss += va.x * va.x + va.y * va.y + va.z * va.z + va.w * va.w + vb.x * vb.x + vb.y * vb.y + vb.z * vb.z + vb.w * vb.w;
              u32x4 o; o.x = pk2(va.x, va.y); o.y = pk2(va.z, va.w); o.z = pk2(vb.x, vb.y); o.w = pk2(vb.z, vb.w);
              *(u32x4*)(mb + row * DM + col) = o;
            }
            ss += __shfl_xor(ss, 16); ss += __shfl_xor(ss, 32);
            if (fq == 0) rss[row] = ss;
          }
        }
      } else if (kind == G_S) {
        bf16_t* S = (bf16_t*)(ws2 + O_S) + ((size_t)grp * NCR + (size_t)pm * 256) * 256;
#pragma unroll
        for (int ai = 0; ai < 2; ++ai)
#pragma unroll
          for (int m = 0; m < 4; ++m) {
            const int r = ai * 128 + wr * 64 + m * 16 + fr;
#pragma unroll
            for (int bj = 0; bj < 2; ++bj) {
              const f32x4 va = acc[ai][bj][m][0], vb = acc[ai][bj][m][1];
              u32x4 o; o.x = pk2(va.x, va.y); o.y = pk2(va.z, va.w); o.z = pk2(vb.x, vb.y); o.w = pk2(vb.z, vb.w);
              *(u32x4*)(S + (size_t)r * 256 + 128 * bj + lc0) = o;
            }
          }
      } else {
        bf16_t* yb = (bf16_t*)(ws2 + O_YB);
#pragma unroll
        for (int ai = 0; ai < 2; ++ai)
#pragma unroll
          for (int m = 0; m < 4; ++m) {
            const size_t cr = (size_t)pm * 256 + ai * 128 + wr * 64 + m * 16 + fr;
#pragma unroll
            for (int bj = 0; bj < 2; ++bj) {
              const int lc = 128 * bj + lc0, t = lc >> 4, i0 = lc & 15;
              const f32x4 va = acc[ai][bj][m][0], vb = acc[ai][bj][m][1];
              u32x4 o; o.x = pk2(gelu_f(va.x), gelu_f(va.y)); o.y = pk2(gelu_f(va.z), gelu_f(va.w));
              o.z = pk2(gelu_f(vb.x), gelu_f(vb.y)); o.w = pk2(gelu_f(vb.z), gelu_f(vb.w));
              *(u32x4*)(yb + (cr * 16 + t) * DM + 16 * grp + i0) = o;
            }
          }
      }
    }
    if (!has_next) break;
    cur = nxt; L = Ln;
  }
  WAIT_V(0);
  if (wr_u == 0) BAR;
  BAR;
}

__device__ __forceinline__ void fixup_phase(const int wv, int layer) {
  PHASE_IDS();
  const float* ge = (const float*)(ws + O_GE); const float* vh = (const float*)(ws + O_VH);
  bf16_t* hdn = (bf16_t*)(ws + O_HDN);
  const int total = 256 * 4 * 2 * (DFF / 4);
  for (int e = bid * 512 + tid; e < total; e += nblk * 512) {
    const int c4 = e % (DFF / 4), pr = e / (DFF / 4), r = pr & 1, blk = pr >> 1, q4 = blk & 3, pm = blk >> 2, col = c4 * 4;
    const f32x4 z = {0.f, 0.f, 0.f, 0.f};
    const bool first = (q4 == 0) && ((pm & 7) == 0);
    const size_t pb = (size_t)blk - 1;
    const f32x4 t0 = first ? z : *(const f32x4*)(ge + (pb * 4 + 0) * DFF + col);
    const f32x4 t1 = first ? z : *(const f32x4*)(ge + (pb * 4 + 1) * DFF + col);
    const f32x4 h0 = *(const f32x4*)(ge + ((size_t)blk * 4 + 2) * DFF + col);
    const f32x4 h1 = *(const f32x4*)(ge + ((size_t)blk * 4 + 3) * DFF + col);
    const f32x4 v = *(const f32x4*)(vh + ((size_t)blk * 2 + r) * DFF + col);
    const f32x4 g0 = r ? h1 : h0, g1 = r ? h0 : t1, g2 = r ? t1 : t0;
    const float* cw = kp->convw + (size_t)layer * 3 * DFF + col;
    const f32x4 c = *(const f32x4*)(kp->convb + (size_t)layer * DFF + col) + *(const f32x4*)cw * g2 + *(const f32x4*)(cw + DFF) * g1 + *(const f32x4*)(cw + 2 * DFF) * g0;
    u32x2 o; o.x = pk2(gelu_f(c.x) * v.x, gelu_f(c.y) * v.y); o.y = pk2(gelu_f(c.z) * v.z, gelu_f(c.w) * v.w);
    *(u32x2*)(hdn + ((size_t)pm * 256 + q4 * 64 + r) * DFF + col) = o;
  }
}

__device__ __forceinline__ void rowpass_phase(const int wv, const int mode, const int layer, const int layout) {
  PHASE_IDS();
  const bool has_m = mode != 0;
  const float* xin = kp->x;
  const float* gpost = (mode == 1 ? kp->n_mix_post : kp->n_ffn_post) + layer * DM;
  const float* gpre = mode == 0 ? kp->n_mix_pre : (mode == 1 ? kp->n_ffn_pre + layer * DM : kp->n_mix_pre + (layer + 1) * DM);
  float* xout = kp->out;
  const int wid = tid >> 6, lane = tid & 63;
#define ROFF(q) (512 * ((q) >> 1) + 8 * lane + 4 * ((q) & 1))
  const bf16_t* mb = (const bf16_t*)(ws + O_MB); const float* rss = (const float*)(ws + O_RSS);
  bf16_t* hb = (bf16_t*)(ws + O_HB); bf16_t* xb = (bf16_t*)(ws + O_XB); float* rs2b = (float*)(ws + O_RS2);
  bf16_t* stg = (bf16_t*)smem;
  f32x4 gpo[4], gpr[4];
#pragma unroll
  for (int q = 0; q < 4; ++q) {
    gpo[q] = has_m ? *(const f32x4*)(gpost + ROFF(q)) : (f32x4){0.f, 0.f, 0.f, 0.f};
    gpr[q] = (layout == 1 || layout == 2) ? *(const f32x4*)(gpre + ROFF(q)) : (f32x4){0.f, 0.f, 0.f, 0.f};
  }
  for (int it = bid; it < NTOK / 32; it += nblk) {
    const size_t tok0 = (size_t)it * 32 + 4 * wid;
    f32x4 xv[4][4]; u32x2 mv[4][4]; float ssv[4];
#pragma unroll
    for (int rr = 0; rr < 4; ++rr) {
      if (!has_m) {
#pragma unroll
        for (int q = 0; q < 4; ++q) xv[rr][q] = __builtin_nontemporal_load((const f32x4*)(xin + (tok0 + rr) * DM + ROFF(q)));
      } else {
#pragma unroll
        for (int qq = 0; qq < 2; ++qq) {
          const u32x4 xr = *(const u32x4*)(xb + (tok0 + rr) * DM + ROFF(2 * qq));
          xv[rr][2 * qq] = (f32x4){bf_lo(xr.x), bf_hi(xr.x), bf_lo(xr.y), bf_hi(xr.y)};
          xv[rr][2 * qq + 1] = (f32x4){bf_lo(xr.z), bf_hi(xr.z), bf_lo(xr.w), bf_hi(xr.w)};
          const u32x4 mr = __builtin_nontemporal_load((const u32x4*)(mb + (tok0 + rr) * DM + ROFF(2 * qq)));
          mv[rr][2 * qq] = (u32x2){mr.x, mr.y}; mv[rr][2 * qq + 1] = (u32x2){mr.z, mr.w};
        }
        ssv[rr] = rss[(size_t)(lane & 15) * NTOK + tok0 + rr];
      }
    }
#pragma unroll
    for (int rr = 0; rr < 4; ++rr) {
      const size_t tok = tok0 + rr; const int tl = 4 * wid + rr;
      if (has_m) {
        float ss = ssv[rr];
        ss += __shfl_xor(ss, 1); ss += __shfl_xor(ss, 2); ss += __shfl_xor(ss, 4); ss += __shfl_xor(ss, 8);
        const float rs = rsqrtf(ss * (1.0f / DM) + RMS_EPS);
#pragma unroll
        for (int q = 0; q < 4; ++q) {
          xv[rr][q].x += bf_lo(mv[rr][q].x) * rs * gpo[q].x; xv[rr][q].y += bf_hi(mv[rr][q].x) * rs * gpo[q].y;
          xv[rr][q].z += bf_lo(mv[rr][q].y) * rs * gpo[q].z; xv[rr][q].w += bf_hi(mv[rr][q].y) * rs * gpo[q].w;
        }
      }
      if (layout == 0) {
#pragma unroll
        for (int q = 0; q < 4; ++q) *(f32x4*)(xout + tok * DM + ROFF(q)) = xv[rr][q];
      } else {
#pragma unroll
        for (int qq = 0; qq < 2; ++qq) { u32x4 o; o.x = pk2(xv[rr][2 * qq].x, xv[rr][2 * qq].y); o.y = pk2(xv[rr][2 * qq].z, xv[rr][2 * qq].w);
          o.z = pk2(xv[rr][2 * qq + 1].x, xv[rr][2 * qq + 1].y); o.w = pk2(xv[rr][2 * qq + 1].z, xv[rr][2 * qq + 1].w); *(u32x4*)(xb + tok * DM + ROFF(2 * qq)) = o; }
        float s2 = 0.f;
#pragma unroll
        for (int q = 0; q < 4; ++q) s2 += xv[rr][q].x * xv[rr][q].x + xv[rr][q].y * xv[rr][q].y + xv[rr][q].z * xv[rr][q].z + xv[rr][q].w * xv[rr][q].w;
        const float rs2 = rsqrtf(wave_sum(s2) * (1.0f / DM) + RMS_EPS);
        if (layout == 3) { if (lane == 0) rs2b[tok] = rs2; continue; }
#pragma unroll
        for (int qq = 0; qq < 2; ++qq) {
          const int q0 = 2 * qq, q1 = 2 * qq + 1;
          u32x4 o; o.x = pk2(xv[rr][q0].x * rs2 * gpr[q0].x, xv[rr][q0].y * rs2 * gpr[q0].y); o.y = pk2(xv[rr][q0].z * rs2 * gpr[q0].z, xv[rr][q0].w * rs2 * gpr[q0].w);
          o.z = pk2(xv[rr][q1].x * rs2 * gpr[q1].x, xv[rr][q1].y * rs2 * gpr[q1].y); o.w = pk2(xv[rr][q1].z * rs2 * gpr[q1].z, xv[rr][q1].w * rs2 * gpr[q1].w);
          if (layout == 1) *(u32x4*)(hb + tok * DM + ROFF(q0)) = o;
          else *(u32x4*)(stg + tl * 1024 + ROFF(q0)) = o;
        }
      }
    }
    if (layout == 2) {
      __syncthreads();
#pragma unroll
      for (int ps = 0; ps < 8; ++ps) {
        const int e = (ps * 512 + tid) * 8, c2 = e >> 14, e1 = e & 16383, gp = e1 >> 9, within = e1 & 511, gl = within >> 8, t = (within & 255) >> 4, i0 = within & 15;
        const u32x4 v = *(const u32x4*)(stg + (c2 * 16 + t) * 1024 + gp * 32 + gl * 16 + i0);
        *(u32x4*)(hb + ((size_t)gp * NCR + (size_t)it * 2 + c2) * 512 + within) = v;
      }
      __syncthreads();
    }
  }
#undef ROFF
}

template <int WIN> __device__ __forceinline__ void pool_item(const bf16_t* __restrict__ base, const float* __restrict__ rsp, bf16_t* __restrict__ dst, const int t0, const f32x4 ga, const f32x4 gb) {
  u32x4 rows[8 + WIN - 1]; float rsv[8 + WIN - 1];
#pragma unroll
  for (int k = 0; k < 8 + WIN - 1; ++k) {
    const int tt = t0 - (WIN - 1) + k;
    rows[k] = (tt >= 0) ? *(const u32x4*)(base + (long)tt * DM) : (u32x4){0u, 0u, 0u, 0u};
    rsv[k] = (tt >= 0) ? rsp[tt] : 0.f;
  }
#define POOL_CVT(c, k) float c[8]; { const u32x4 _v = rows[k]; const float _r = rsv[k]; \
    c[0] = bf_lo(_v.x) * _r * ga.x; c[1] = bf_hi(_v.x) * _r * ga.y; c[2] = bf_lo(_v.y) * _r * ga.z; c[3] = bf_hi(_v.y) * _r * ga.w; \
    c[4] = bf_lo(_v.z) * _r * gb.x; c[5] = bf_hi(_v.z) * _r * gb.y; c[6] = bf_lo(_v.w) * _r * gb.z; c[7] = bf_hi(_v.w) * _r * gb.w; }
  float sum[8];
#pragma unroll
  for (int u = 0; u < 8; ++u) sum[u] = 0.f;
#pragma unroll
  for (int k = 0; k < WIN - 1; ++k) {
    POOL_CVT(c, k)
#pragma unroll
    for (int u = 0; u < 8; ++u) sum[u] += c[u];
  }
#pragma unroll
  for (int u = 0; u < 8; ++u) {
    const int t = t0 + u;
    POOL_CVT(c, WIN - 1 + u)
    const float ic = (t + 1 >= WIN) ? (1.0f / (float)WIN) : 1.0f / (float)(t + 1);
#pragma unroll
    for (int e = 0; e < 8; ++e) sum[e] += c[e];
    u32x4 o; o.x = pk2(sum[0] * ic - c[0], sum[1] * ic - c[1]); o.y = pk2(sum[2] * ic - c[2], sum[3] * ic - c[3]);
    o.z = pk2(sum[4] * ic - c[4], sum[5] * ic - c[5]); o.w = pk2(sum[6] * ic - c[6], sum[7] * ic - c[7]);
    *(u32x4*)(dst + (long)t * DM) = o;
    POOL_CVT(w, u)
#pragma unroll
    for (int e = 0; e < 8; ++e) sum[e] -= w[e];
  }
#undef POOL_CVT
}
__device__ __forceinline__ void poolprep_phase(const int wv, const int layer) {
  PHASE_IDS();
  const bf16_t* xb = (const bf16_t*)(ws + O_XB); bf16_t* yb = (bf16_t*)(ws + O_YB); const float* rs2b = (const float*)(ws + O_RS2);
  const int oct = tid & 127, sub = tid >> 7, grp = oct >> 5;
  const float* gp = kp->n_mix_pre + layer * DM + oct * 8;
  const f32x4 ga = *(const f32x4*)gp, gb = *(const f32x4*)(gp + 4);
  for (int it = bid; it < NB * 64; it += nblk) {
    const int b = it >> 6, seg = it & 63, t0 = seg * 32 + sub * 8;
    const bf16_t* base = xb + (size_t)b * SEQ * DM + oct * 8;
    const float* rsp = rs2b + (size_t)b * SEQ;
    bf16_t* dst = yb + (size_t)b * SEQ * DM + oct * 8;
    if (grp == 0) pool_item<2>(base, rsp, dst, t0, ga, gb);
    else if (grp == 1) pool_item<4>(base, rsp, dst, t0, ga, gb);
    else if (grp == 2) pool_item<8>(base, rsp, dst, t0, ga, gb);
    else pool_item<16>(base, rsp, dst, t0, ga, gb);
  }
}

__device__ __forceinline__ void scan_phase(const int wv, int j2) {
  PHASE_IDS();
  const bf16_t* S = (const bf16_t*)(ws + O_S); bf16_t* H = (bf16_t*)(ws + O_HST);
  const float* AT = (const float*)(ws + O_AT) + (size_t)j2 * 64 * 64 * 2;
  for (int idx = bid * 512 + tid; idx < 32 * NB * 128; idx += nblk * 512) {
    const int gp = idx >> 12, rem = idx & 4095, b = rem >> 7, q = rem & 127, gl = q >> 6, pp = q & 63;
    const int g = 2 * gp + gl;
    const float ar = AT[(g * 64 + pp) * 2], ai = AT[(g * 64 + pp) * 2 + 1];
    float hr = 0.f, hi = 0.f;
    const size_t base = ((size_t)gp * NCR + (size_t)b * 128) * 256 + gl * 128 + pp;
    for (int c0 = 0; c0 < 128; c0 += 16) {
      bf16_t srv[16], siv[16];
#pragma unroll
      for (int u = 0; u < 16; ++u) { const size_t off = base + (size_t)(c0 + u) * 256; srv[u] = S[off]; siv[u] = S[off + 64]; }
#pragma unroll
      for (int u = 0; u < 16; ++u) {
        const size_t off = base + (size_t)(c0 + u) * 256;
        H[off] = (bf16_t)(pk2(hr, hr) & 0xffffu); H[off + 64] = (bf16_t)(pk2(hi, hi) & 0xffffu);
        const float sr = __uint_as_float((unsigned)srv[u] << 16), si = __uint_as_float((unsigned)siv[u] << 16);
        const float nr = ar * hr - ai * hi + sr, ni = ar * hi + ai * hr + si;
        hr = nr; hi = ni;
      }
    }
  }
}

__device__ __forceinline__ void transpose_item(const float* W, int ldw, int k0, int c0, bf16_t* dst, int ldd, float* scr, int lane, const float* gk = nullptr) {
#pragma unroll 8
  for (int i = 0; i < 32; ++i) { const int kk = 2 * i + (lane >> 5); scr[kk * 33 + (lane & 31)] = W[(size_t)(k0 + kk) * ldw + c0 + (lane & 31)] * (gk ? gk[k0 + kk] : 1.0f); }
  asm volatile("s_waitcnt lgkmcnt(0)" ::: "memory");
  const int c = lane & 7;
#pragma unroll
  for (int jj = 0; jj < 4; ++jj) {
    const int n = (lane >> 3) + 8 * jj; const float* s = scr + (8 * c) * 33 + perm32(n);
    u32x4 o; o.x = pk2(s[0 * 33], s[1 * 33]); o.y = pk2(s[2 * 33], s[3 * 33]); o.z = pk2(s[4 * 33], s[5 * 33]); o.w = pk2(s[6 * 33], s[7 * 33]);
    *(u32x4*)(dst + (size_t)n * ldd + 8 * c) = o;
  }
  asm volatile("s_waitcnt lgkmcnt(0)" ::: "memory");
}

__device__ __forceinline__ void prep_phase(const int wv) {
  PHASE_IDS();
  const int wid = tid >> 6, lane = tid & 63;
  float* lf = (float*)smem;
  float* apr = lf;
  float* api = apr + 17 * 64;
  float* Bbr = api + 17 * 64;
  float* Bbi = Bbr + 1024;
  float* Cr = Bbi + 1024;
  float* Ci = Cr + 1024;
  float* Kk = Ci + 1024;
  float* fre = Kk + 4096;
  float* fim = fre + 64;
  for (int it = bid; it < 128; it += nblk) {
    const int j = it >> 6, g = it & 63, gp = g >> 1, gl = g & 1;
    if (tid < 64) {
      const int pp = tid;
      const float lr = kp->lam_re[(j * 64 + g) * 64 + pp], li = kp->lam_im[(j * 64 + g) * 64 + pp];
      const float dt = expf(kp->log_dt[j * 64 + g]);
      const float mag = expf(lr * dt);
      float sn, cs; sincosf(li * dt, &sn, &cs);
      const float ar = mag * cs, ai = mag * sn;
      const float den = lr * lr + li * li, nr = ar - 1.0f, ni = ai;
      fre[pp] = (nr * lr + ni * li) / den; fim[pp] = (ni * lr - nr * li) / den;
      float pr = 1.0f, pi = 0.0f;
      for (int k = 0; k <= 16; ++k) { apr[k * 64 + pp] = pr; api[k * 64 + pp] = pi; const float t = pr * ar - pi * ai; pi = pr * ai + pi * ar; pr = t; }
      float* AT = (float*)(ws + O_AT) + ((size_t)(j * 64 + g) * 64 + pp) * 2;
      AT[0] = apr[16 * 64 + pp]; AT[1] = api[16 * 64 + pp];
    }
    __syncthreads();
    for (int e = tid; e < 1024; e += 512) {
      const int pp = e >> 4;
      const float br = kp->b_re[(size_t)(j * 64 + g) * 1024 + e], bi = kp->b_im[(size_t)(j * 64 + g) * 1024 + e];
      Bbr[e] = fre[pp] * br - fim[pp] * bi; Bbi[e] = fre[pp] * bi + fim[pp] * br;
      Cr[e] = kp->c_re[(size_t)(j * 64 + g) * 1024 + e]; Ci[e] = kp->c_im[(size_t)(j * 64 + g) * 1024 + e];
    }
    __syncthreads();
    for (int e = tid; e < 4096; e += 512) {
      const int k = e >> 8, i = (e >> 4) & 15, jj = e & 15;
      float a = 0.f;
      for (int pp = 0; pp < 64; ++pp) {
        const float wr_ = apr[k * 64 + pp] * Bbr[pp * 16 + jj] - api[k * 64 + pp] * Bbi[pp * 16 + jj];
        const float wi_ = apr[k * 64 + pp] * Bbi[pp * 16 + jj] + api[k * 64 + pp] * Bbr[pp * 16 + jj];
        a += Cr[i * 64 + pp] * wr_ - Ci[i * 64 + pp] * wi_;
      }
      if (k == 0 && i == jj) a += kp->s5d[(size_t)j * DM + 16 * g + i];
      Kk[e] = a;
    }
    __syncthreads();
    bf16_t* ME = (bf16_t*)(ws + O_ME) + ((size_t)j * 64 + g) * 256 * 384;
    for (int v = tid; v < 256 * 48; v += 512) {
      const int R = v / 48, kc0 = (v % 48) * 8, lr_ = slot2col(R), t = lr_ >> 4, i = lr_ & 15;
      float val[8];
#pragma unroll
      for (int u = 0; u < 8; ++u) {
        const int kc = kc0 + u;
        if (kc < 256) { const int s = kc >> 4, jj = kc & 15; val[u] = (s <= t) ? Kk[((t - s) * 16 + i) * 16 + jj] : 0.f; }
        else {
          const int q = kc - 256, pp = q & 63;
          const float alr = apr[(t + 1) * 64 + pp], ali = api[(t + 1) * 64 + pp];
          val[u] = (q < 64) ? (Cr[i * 64 + pp] * alr - Ci[i * 64 + pp] * ali) : (-Cr[i * 64 + pp] * ali - Ci[i * 64 + pp] * alr);
        }
      }
      u32x4 o; o.x = pk2(val[0], val[1]); o.y = pk2(val[2], val[3]); o.z = pk2(val[4], val[5]); o.w = pk2(val[6], val[7]);
      *(u32x4*)(ME + (size_t)R * 384 + kc0) = o;
    }
    bf16_t* FB = (bf16_t*)(ws + O_FBD) + ((size_t)j * 32 + gp) * 256 * 512;
    for (int v = tid; v < 128 * 64; v += 512) {
      const int R = gl * 128 + (v >> 6), kc0 = (v & 63) * 8, lr_ = slot2col(R), q = lr_ & 127, pp = q & 63;
      u32x4 o = {0u, 0u, 0u, 0u};
      if ((kc0 >> 8) == gl) {
        const int s = (kc0 & 255) >> 4, j0 = kc0 & 15;
        const float alr = apr[(15 - s) * 64 + pp], ali = api[(15 - s) * 64 + pp];
        float val[8];
#pragma unroll
        for (int u = 0; u < 8; ++u) {
          const float br = Bbr[pp * 16 + j0 + u], bi = Bbi[pp * 16 + j0 + u];
          val[u] = (q < 64) ? (alr * br - ali * bi) : (alr * bi + ali * br);
        }
        o.x = pk2(val[0], val[1]); o.y = pk2(val[2], val[3]); o.z = pk2(val[4], val[5]); o.w = pk2(val[6], val[7]);
      }
      *(u32x4*)(FB + (size_t)R * 512 + kc0) = o;
    }
    __syncthreads();
  }
  __syncthreads();
  float* scr = (float*)smem + wid * (64 * 33);
  const int gw = bid * 8 + wid, ngw = nblk * 8;
  constexpr int I_W1 = 16 * 176, I_W2 = 44 * 32, I_WG = 16 * 32, I_WP = 4 * 8;
  constexpr int NITEMS = 4 * I_W1 + 4 * I_W2 + 2 * I_WG + 8 * I_WP;
  for (int it = gw; it < NITEMS; it += ngw) {
    int r = it;
    if (r < 4 * I_W1) {
      const int layer = r / I_W1, q = r % I_W1, kb = q / 176, nb = q % 176, n0 = nb * 32, jt = n0 >> 8, l0 = n0 & 255;
      const float* W = (l0 < 128 ? kp->wgate : kp->wval) + (size_t)layer * DM * DFF;
      transpose_item(W, DFF, kb * 64, 128 * jt + (l0 & 127), (bf16_t*)(ws + O_W1T) + ((size_t)layer * 5632 + n0) * 1024 + kb * 64, 1024, scr, lane, kp->n_ffn_pre + layer * DM);
      continue;
    }
    r -= 4 * I_W1;
    if (r < 4 * I_W2) {
      const int layer = r / I_W2, q = r % I_W2, kb = q / 32, nb = q % 32;
      transpose_item(kp->wdown + (size_t)layer * DFF * DM, DM, kb * 64, nb * 32, (bf16_t*)(ws + O_W2T) + ((size_t)layer * 1024 + nb * 32) * DFF + kb * 64, DFF, scr, lane);
      continue;
    }
    r -= 4 * I_W2;
    if (r < 2 * I_WG) {
      const int j = r / I_WG, q = r % I_WG, kb = q / 32, nb = q % 32;
      transpose_item(kp->wglu + (size_t)j * DM * DM, DM, kb * 64, nb * 32, (bf16_t*)(ws + O_WGT) + ((size_t)j * 1024 + nb * 32) * 1024 + kb * 64, 1024, scr, lane);
      continue;
    }
    r -= 2 * I_WG;
    { const int jg = r / I_WP, q = r % I_WP, kb = q / 8, nb = q % 8;
      transpose_item(kp->poolw + (size_t)jg * 256 * 256, 256, kb * 64, nb * 32, (bf16_t*)(ws + O_WPT) + ((size_t)jg * 256 + nb * 32) * 256 + kb * 64, 256, scr, lane); }
  }
  __syncthreads();
}

#define XB_TMO      128
#define XB_XCNT(j)  (256  + 64 * (j))
#define XB_XSUB(j)  (1280 + 64 * (j))
#define XB_XGEN(j)  (2304 + 64 * (j))
#define XB_TOP      3328
#define XB_TOPGEN   3392
#define XCD_BAR_WORDS 3456
#define XB_SPIN_CAP (1u << 18)
__device__ __forceinline__ unsigned xb_ld(unsigned* p) { return __hip_atomic_load(p, __ATOMIC_RELAXED, __HIP_MEMORY_SCOPE_AGENT); }
__device__ __forceinline__ unsigned xb_add(unsigned* p, unsigned v) { return __hip_atomic_fetch_add(p, v, __ATOMIC_RELAXED, __HIP_MEMORY_SCOPE_AGENT); }
__device__ __forceinline__ unsigned xb_xcc_id() { return (unsigned)__builtin_amdgcn_s_getreg((3 << 11) | 20) & 0xFu; }
#define XB_SPIN(cond, bar) do { unsigned _sp = 0; while (cond) { __builtin_amdgcn_s_sleep(1); \
    if ((++_sp & 255u) == 0u) { if (xb_ld(&(bar)[XB_TMO])) break; if (_sp > XB_SPIN_CAP) { atomicAdd(&(bar)[XB_TMO], 1u); break; } } } } while (0)
typedef volatile __attribute__((address_space(3))) unsigned* XST;
#define XB_ST() ((XST)((__attribute__((address_space(3))) unsigned char*)smem + 131072))
__device__ __forceinline__ void xcd_census(unsigned* bar, unsigned x, unsigned G, unsigned& nloc, unsigned& nx) {
  unsigned sum, cnt, mine, sp = 0u;
  for (;;) {
    sum = 0u; cnt = 0u; mine = 0u;
#pragma unroll
    for (unsigned j = 0; j < 16; ++j) { const unsigned c = xb_ld(&bar[XB_XCNT(j)]); sum += c; cnt += (c > 0u) ? 1u : 0u; mine = (j == x) ? c : mine; }
    if (sum == G) break;
    __builtin_amdgcn_s_sleep(1);
    if ((++sp & 255u) == 0u) { if (xb_ld(&bar[XB_TMO])) break; if (sp > XB_SPIN_CAP) { atomicAdd(&bar[XB_TMO], 1u); break; } }
  }
  nloc = mine > 0u ? mine : 1u; nx = cnt > 0u ? cnt : 1u;
}
__device__ __forceinline__ void gsync_init(const int wv) {
  PHASE_IDS();
  if (tid == 0) { XST st = XB_ST(); st[0] = 0u; st[1] = 0u; (void)xb_add(&((unsigned*)(ws + O_CTR))[XB_XCNT(xb_xcc_id())], 1u); }
  __syncthreads();
}
__device__ __forceinline__ void gsync(const int wv) {
  PHASE_IDS();
  unsigned* bar = (unsigned*)(ws + O_CTR);
  asm volatile("s_waitcnt vmcnt(0)" ::: "memory");
  __syncthreads();
  if (tid == 0) {
    const unsigned x = xb_xcc_id();
    XST st = XB_ST();
    __builtin_amdgcn_s_waitcnt(0);
    unsigned nloc = st[0], nx = st[1];
    if (nloc == 0u) { xcd_census(bar, x, (unsigned)nblk, nloc, nx); st[0] = nloc; st[1] = nx; }
    const unsigned old = xb_add(&bar[XB_XSUB(x)], 1u);
    const unsigned gen = old / nloc;
    if (old + 1u == (gen + 1u) * nloc) {
      __builtin_amdgcn_fence(__ATOMIC_RELEASE, "agent");
      asm volatile("s_waitcnt vmcnt(0)" ::: "memory");
      const unsigned og = xb_add(&bar[XB_TOP], 1u);
      const unsigned tg = og / nx;
      if (og + 1u == (tg + 1u) * nx) xb_add(&bar[XB_TOPGEN], 1u);
      else XB_SPIN(xb_ld(&bar[XB_TOPGEN]) == tg, bar);
      __builtin_amdgcn_fence(__ATOMIC_ACQUIRE, "agent");
      xb_add(&bar[XB_XGEN(x)], 1u);
      asm volatile("s_waitcnt vmcnt(0)" ::: "memory");
    } else {
      XB_SPIN(xb_ld(&bar[XB_XGEN(x)]) == gen, bar);
      __builtin_amdgcn_fence(__ATOMIC_ACQUIRE, "agent");
      asm volatile("s_waitcnt vmcnt(0)" ::: "memory");
    }
  }
  __syncthreads();
}

#ifndef PROBE_KIND
#define PROBE_KIND 0
#endif
#define T0(k) if ((PROBE_KIND >> (k)) & 1) tst = __builtin_amdgcn_s_memrealtime();
#define T1(k) if ((PROBE_KIND >> (k)) & 1) tacc += __builtin_amdgcn_s_memrealtime() - tst;
__global__ void __launch_bounds__(512, 2) mega(Params p) {
  cg::grid_group grid = cg::this_grid();
  const int wv = __builtin_amdgcn_readfirstlane((int)(threadIdx.x >> 6));
  unsigned long long tacc = 0, tst = 0; (void)tst;
  gsync_init(wv);
  T0(10) prep_phase(wv);
  rowpass_phase(wv, 0, 0, 2);
  gsync(wv); T1(10)
  { KP_GET(kq); if (kq->ws == nullptr) grid.sync(); }
  for (int i = 0; i < DEPTH; ++i) {
    if ((i & 1) == 0) {
      T0(4) gemm_phase(wv, G_S, i); gsync(wv); T1(4)
      T0(5) scan_phase(wv, i >> 1); gsync(wv); T1(5)
      T0(6) gemm_phase(wv, G_Y, i); gsync(wv); T1(6)
      T0(7) gemm_phase(wv, G_GLU, i); gsync(wv); T1(7)
    } else {
      T0(8) poolprep_phase(wv, i); gsync(wv); T1(8)
      T0(9) gemm_phase(wv, G_POOL, i); gsync(wv); T1(9)
    }
    T0(3) rowpass_phase(wv, 1, i, 3); gsync(wv); T1(3)
    T0(1) gemm_phase(wv, G_FFN1, i); gsync(wv); T1(1)
    T0(11) fixup_phase(wv, i); gsync(wv); T1(11)
    T0(2) gemm_phase(wv, G_FFN2, i); gsync(wv); T1(2)
    T0(3)
    if (i < DEPTH - 1) { rowpass_phase(wv, 2, i, ((i + 1) & 1) ? 3 : 2); gsync(wv); }
    else rowpass_phase(wv, 2, i, 0);
    T1(3)
  }
  if ((PROBE_KIND >> 12) & 1) { gsync(wv); tst = __builtin_amdgcn_s_memrealtime(); for (int k = 0; k < 100; ++k) gsync(wv); tacc = __builtin_amdgcn_s_memrealtime() - tst; }
  if (PROBE_KIND != 0) { PHASE_IDS(); if (bid == 0 && tid == 0) kp->out[0] += (float)tacc * 1e-4f; }
}

extern "C" void kernel_launch(void* const* d_in, const int* in_sizes, int n_in, void* d_out, int out_size, void* d_ws, size_t ws_size, hipStream_t stream) {
  static int grid_blocks = 0;
  if (!grid_blocks) {
    if (n_in != 22 || out_size != NTOK * DM || ws_size < WS_END) {
      fprintf(stderr, "kernel_launch: unexpected shapes (n_in %d out %d ws %zu need %zu)\n", n_in, out_size, ws_size, (size_t)WS_END);
      grid_blocks = -1; return;
    }
    int dev = 0, cus = 0, per_cu = 0;
    (void)hipGetDevice(&dev);
    (void)hipDeviceGetAttribute(&cus, hipDeviceAttributeMultiprocessorCount, dev);
    (void)hipFuncSetAttribute((const void*)mega, hipFuncAttributeMaxDynamicSharedMemorySize, LDS_BYTES);
    (void)hipOccupancyMaxActiveBlocksPerMultiprocessor(&per_cu, (const void*)mega, 512, LDS_BYTES);
    if (per_cu < 1) fprintf(stderr, "kernel_launch: occupancy query says %d blocks/CU\n", per_cu);
    grid_blocks = cus;
  }
  if (grid_blocks < 0) return;
  Params p{};
  const float** f = (const float**)&p;
  for (int i = 0; i < 22; ++i) f[i] = (const float*)d_in[i];
  p.out = (float*)d_out; p.ws = (unsigned char*)d_ws;
  (void)hipMemsetAsync((unsigned char*)d_ws + O_CTR, 0, 16384, stream);
  void* args[] = {&p};
  hipError_t e = hipLaunchCooperativeKernel((void*)mega, dim3(grid_blocks), dim3(512), args, LDS_BYTES, stream);
  if (e != hipSuccess) fprintf(stderr, "cooperative launch failed: %s (grid %d)\n", hipGetErrorString(e), grid_blocks);
}
```
